# Optimizing an MI355X kernel written in HIP

```python
import jax, jax.numpy as jnp
from jax import lax
import numpy as np

D_MODEL = 1024
BATCH = 32
SEQ = 2048
DEPTH = 4

BRANCH_WIDTH = D_MODEL // 2
N_BRANCH = 3
GM_CHUNK = 128
GM_GROUPS = 4
GM_GROUP_WIDTH = BRANCH_WIDTH // GM_GROUPS
SB_HEAD_DIM = 64
SB_HEADS = BRANCH_WIDTH // SB_HEAD_DIM
SB_QBLOCK = 128
POOL_WINDOWS = (2, 4, 8, 16)
POOL_GROUPS = len(POOL_WINDOWS)
POOL_GROUP_WIDTH = BRANCH_WIDTH // POOL_GROUPS
D_FF = -(-8 * D_MODEL // (3 * 256)) * 256
N_MOD = 6
EPS = 1e-6
IN_SIZES = (BRANCH_WIDTH,) * 6 + (N_BRANCH * D_MODEL,)
IN_SPLITS = tuple(int(s) for s in np.cumsum(IN_SIZES)[:-1])
IN_COLS = int(sum(IN_SIZES))

kernel_name = "hybrid_gmlp_stickbreak_pool_adaln"


def rmsnorm(x, g):
    xf = x.astype(jnp.float32)
    xf = xf * lax.rsqrt(jnp.mean(xf * xf, axis=-1, keepdims=True) + EPS)
    return xf.astype(x.dtype) * g


def layernorm(x, g, b):
    xf = x.astype(jnp.float32)
    mu = jnp.mean(xf, axis=-1, keepdims=True)
    xc = xf - mu
    xf = xc * lax.rsqrt(jnp.mean(xc * xc, axis=-1, keepdims=True) + EPS)
    return xf.astype(x.dtype) * g + b


def gmlp_mixer(u, v, ln_g, ln_b, w_s, b_s):
    B, S, _ = v.shape
    v = layernorm(v, ln_g, ln_b)
    vc = v.reshape(B, S // GM_CHUNK, GM_CHUNK, GM_GROUPS, GM_GROUP_WIDTH)
    causal = jnp.tril(jnp.ones((GM_CHUNK, GM_CHUNK), dtype=bool))
    w = jnp.where(causal[None], w_s, 0.0)
    s = jnp.einsum('gts,bnsgc->bntgc', w, vc) + b_s.T[:, :, None]
    return u * s.reshape(B, S, BRANCH_WIDTH)


def stick_breaking_attention(q, k, v):
    B, S, _ = q.shape
    to_heads = lambda a: a.reshape(B, S, SB_HEADS, SB_HEAD_DIM).transpose(0, 2, 1, 3)
    q, k, v = to_heads(q), to_heads(k), to_heads(v)
    scale = SB_HEAD_DIM ** -0.5
    outs = []
    for i in range(S // SB_QBLOCK):
        start, end = i * SB_QBLOCK, (i + 1) * SB_QBLOCK
        qb = q[:, :, start:end].astype(jnp.float32)
        kb = k[:, :, :end].astype(jnp.float32)
        z = jnp.einsum('bhqd,bhkd->bhqk', qb, kb) * scale
        t_pos = start + jnp.arange(SB_QBLOCK)[:, None]
        s_pos = jnp.arange(end)[None, :]
        mask = s_pos < t_pos
        log_beta = jax.nn.log_sigmoid(z)
        log_one_minus = jnp.where(mask, log_beta - z, 0.0)
        suffix = lax.cumsum(log_one_minus, axis=3, reverse=True) - log_one_minus
        a = jnp.where(mask, jnp.exp(log_beta + suffix), 0.0)
        outs.append(jnp.einsum('bhqk,bhkd->bhqd', a.astype(v.dtype), v[:, :, :end]))
    o = jnp.concatenate(outs, axis=2)
    return o.transpose(0, 2, 1, 3).reshape(B, S, BRANCH_WIDTH)


def pool_mixer(xp, w_pool, pool_scale):
    B, S, _ = xp.shape
    xg = xp.astype(jnp.float32).reshape(B, S, POOL_GROUPS, POOL_GROUP_WIDTH)
    prefix = jnp.cumsum(xg, axis=1)
    pos = jnp.arange(S)
    diffs = []
    for g, w in enumerate(POOL_WINDOWS):
        pg = prefix[:, :, g]
        lagged = jnp.pad(pg[:, :S - w], ((0, 0), (w, 0), (0, 0)))
        count = jnp.minimum(pos + 1, w).astype(jnp.float32)[None, :, None]
        diffs.append((pg - lagged) / count - xg[:, :, g])
    d = jnp.stack(diffs, axis=2).astype(xp.dtype)
    y = jnp.einsum('bsgc,gcd->bsgd', d, w_pool)
    return y.reshape(B, S, BRANCH_WIDTH) * pool_scale


def setup_inputs(seed: int = 0) -> dict:
    key = jax.random.key(seed)
    ks = jax.random.split(key, 20)
    f32 = jnp.float32
    nrm = lambda k, shape, s: jax.random.normal(k, shape, f32) * s
    L, D, W = DEPTH, D_MODEL, BRANCH_WIDTH
    return {
        "x": nrm(ks[0], (BATCH, SEQ, D), 1.0),
        "c": nrm(ks[1], (BATCH, D), 1.0),
        "rms_g1": 1.0 + nrm(ks[2], (L, D), 0.02),
        "rms_g2": 1.0 + nrm(ks[3], (L, D), 0.02),
        "w_ada": nrm(ks[4], (L, D, N_MOD * D), 0.5 * D ** -0.5),
        "b_ada": nrm(ks[5], (L, N_MOD * D), 0.02),
        "w_in": nrm(ks[6], (L, D, IN_COLS), D ** -0.5),
        "gm_ln_g": 1.0 + nrm(ks[7], (L, W), 0.02),
        "gm_ln_b": nrm(ks[8], (L, W), 0.02),
        "gm_w_spatial": nrm(ks[9], (L, GM_GROUPS, GM_CHUNK, GM_CHUNK), GM_CHUNK ** -0.5),
        "gm_b_spatial": 1.0 + nrm(ks[10], (L, GM_GROUPS, GM_CHUNK), 0.02),
        "pool_w": nrm(ks[11], (L, POOL_GROUPS, POOL_GROUP_WIDTH, POOL_GROUP_WIDTH), POOL_GROUP_WIDTH ** -0.5),
        "pool_scale": 1.0 + nrm(ks[12], (L, W), 0.02),
        "w_branch": nrm(ks[13], (L, N_BRANCH, W, D), W ** -0.5),
        "w_out": nrm(ks[14], (L, D, D), D ** -0.5),
        "w_ffn_in": nrm(ks[15], (L, D, 2 * D_FF), D ** -0.5),
        "w_ffn_out": nrm(ks[16], (L, D_FF, D), D_FF ** -0.5),
        "final_g": 1.0 + nrm(ks[17], (D,), 0.02),
    }


def reference(x, c, rms_g1, rms_g2, w_ada, b_ada, w_in, gm_ln_g, gm_ln_b, gm_w_spatial, gm_b_spatial,
              pool_w, pool_scale, w_branch, w_out, w_ffn_in, w_ffn_out, final_g):
    B, S, D = x.shape
    c_act = jax.nn.silu(c)
    for l in range(DEPTH):
        mod = c_act @ w_ada[l] + b_ada[l]
        sh1, sc1, gt1, sh2, sc2, gt2 = [m[:, None, :] for m in jnp.split(mod, N_MOD, axis=-1)]

        h = rmsnorm(x, rms_g1[l]) * (1.0 + sc1) + sh1
        proj = h @ w_in[l]
        gm_u, gm_v, sb_q, sb_k, sb_v, pool_in, gate_logits = jnp.split(proj, IN_SPLITS, axis=-1)
        branches = (
            gmlp_mixer(jax.nn.gelu(gm_u), jax.nn.gelu(gm_v), gm_ln_g[l], gm_ln_b[l],
                       gm_w_spatial[l], gm_b_spatial[l]),
            stick_breaking_attention(sb_q, sb_k, sb_v),
            pool_mixer(pool_in, pool_w[l], pool_scale[l]),
        )
        gates = jax.nn.sigmoid(gate_logits.reshape(B, S, N_BRANCH, D))
        merged = sum(gates[:, :, n] * (branches[n] @ w_branch[l, n]) for n in range(N_BRANCH))
        x = x + gt1 * (merged @ w_out[l])

        h2 = rmsnorm(x, rms_g2[l]) * (1.0 + sc2) + sh2
        f_gate, f_up = jnp.split(h2 @ w_ffn_in[l], 2, axis=-1)
        x = x + gt2 * ((jax.nn.silu(f_gate) * f_up) @ w_ffn_out[l])
    return rmsnorm(x, final_g)
```

```cpp
#include <hip/hip_runtime.h>
#include <hip/hip_cooperative_groups.h>
#include <cstdio>
#include <cstdint>
namespace cg = cooperative_groups;

#define LAS __attribute__((address_space(3)))
typedef unsigned short bf16_t;
typedef short bf16x8 __attribute__((ext_vector_type(8)));
typedef short s16x4 __attribute__((ext_vector_type(4)));
typedef float f32x4 __attribute__((ext_vector_type(4)));
typedef float f32x2 __attribute__((ext_vector_type(2)));
typedef float f32x16 __attribute__((ext_vector_type(16)));
typedef unsigned u32x4 __attribute__((ext_vector_type(4)));
typedef unsigned u32x2 __attribute__((ext_vector_type(2)));

constexpr int NB = 32, SEQ = 2048, DM = 1024, NTOK = NB * SEQ, NL = 4, BW = 512, FF = 2816;
constexpr int ACT_LD = 2560;
constexpr int MID_LD = 3072;
constexpr int WMG_LD = 4608;
constexpr int NMOD = 6 * DM;
constexpr float EPS = 1e-6f;
constexpr float LOG2E = 1.4426950408889634f;

constexpr size_t MiB = (size_t)1 << 20;
constexpr size_t WS_MOD = 1 * MiB;
constexpr size_t WS_WSP = 4 * MiB;
constexpr size_t WS_WPT = 5 * MiB;
constexpr size_t WS_WIN = 6 * MiB;
constexpr size_t WS_WMG = 30 * MiB;
constexpr size_t WS_WOUT = 66 * MiB;
constexpr size_t WS_WFI = 74 * MiB;
constexpr size_t WS_WFO = 118 * MiB;
constexpr size_t WS_ACT = 140 * MiB;
constexpr size_t WS_MID = 460 * MiB;
constexpr size_t WS_SCR = 460 * MiB;
constexpr size_t SCR_PER_WG = 384 * 1024;
static_assert((size_t)SEQ * MID_LD * 2 == 32 * SCR_PER_WG, "a batch's MID block holds exactly 32 scratch slots");
constexpr size_t WS_MRG = 844 * MiB;
constexpr size_t WS_F = 460 * MiB;
constexpr size_t WS_END = 972 * MiB;
constexpr int MAX_GRID = 256;

constexpr int LDS_BYTES = 147456;

__device__ __forceinline__ unsigned f2bf(float f) { unsigned u = __builtin_bit_cast(unsigned, f); return (u + 0x7fffu + ((u >> 16) & 1u)) >> 16; }
typedef __bf16 bf16x2_t __attribute__((ext_vector_type(2)));
__device__ __forceinline__ unsigned pk2(float lo, float hi) { const f32x2 v = {lo, hi}; return __builtin_bit_cast(unsigned, __builtin_convertvector(v, bf16x2_t)); }
__device__ __forceinline__ float bflo(unsigned u) { return __builtin_bit_cast(float, u << 16); }
__device__ __forceinline__ float bfhi(unsigned u) { return __builtin_bit_cast(float, u & 0xffff0000u); }
__device__ __forceinline__ float fast_sigmoid(float x) { return __builtin_amdgcn_rcpf(1.0f + __builtin_amdgcn_exp2f(-LOG2E * x)); }
__device__ __forceinline__ float gelu_tanh(float x) {
    const float u = x * (1.0f + 0.044715f * x * x);
    return x * __builtin_amdgcn_rcpf(1.0f + __builtin_amdgcn_exp2f(-2.302208198f * u));
}
__device__ __forceinline__ int opaque_tid() { int t = threadIdx.x; asm volatile("" : "+v"(t)); return t; }
__device__ __forceinline__ float shx(float v, int lane, int o) { return __builtin_bit_cast(float, __builtin_amdgcn_ds_bpermute((lane ^ o) << 2, __builtin_bit_cast(int, v))); }
__device__ __forceinline__ float wave_sum(float v, int lane) {
#pragma unroll
    for (int o = 32; o >= 1; o >>= 1) v += shx(v, lane, o);
    return v;
}

namespace pg8 {
constexpr int BM = 256, BK = 64, HALF = 128, HTB = HALF * BK * 2, STAGE_BYTES = 8 * HTB, NXCD = 8, WGM = 8;
__host__ __device__ __forceinline__ int lds_byte(int r, int c) { const int st = (r >> 4) * 2 + (c >> 5), rr = r & 15, cc = c & 31, ob = rr * 64 + cc * 2; return st * 1024 + (ob ^ (((ob >> 9) & 1) << 5)); }
__host__ __device__ __forceinline__ void stage_rc(int b, int& R, int& C) { const int st = b / 1024, sb = b % 1024, swz = sb ^ (((sb >> 9) & 1) << 5); R = (st >> 1) * 16 + swz / 64; C = (st & 1) * 32 + (swz % 64) / 2; }
__host__ __device__ __forceinline__ int perm32(int rho) { const int n = rho >> 4, i = rho & 15; return 8 * (i >> 2) + 4 * n + (i & 3); }

struct Unit { int pm, pn, ak, bk, nt, kind; };
struct Gemm { const bf16_t* A; const bf16_t* Bt; int lda, ldb; };

__host__ __device__ __forceinline__ void tile_map(int nM, int nN, int L, int& pm, int& pn) {
    const int nwg = nM * nN; int wgid = L;
    { const int q = nwg / NXCD, r = nwg % NXCD, xcd = wgid % NXCD, off = wgid / NXCD; wgid = (xcd < r ? xcd * (q + 1) : r * (q + 1) + (xcd - r) * q) + off; }
    const int nig = WGM * nN, gid = wgid / nig, fm = gid * WGM, gsz = (nM - fm) < WGM ? (nM - fm) : WGM;
    pm = fm + ((wgid % nig) % gsz); pn = (wgid % nig) / gsz;
}
struct XInfo { int xi, nx, r, cnt, nbx; };
struct StaticOrder {
    XInfo X; int nN, nwg, nt, ak, bk;
    __device__ void init(const XInfo& X_, int N, int nt_, int ak_ = 0, int bk_ = 0) { X = X_; nN = N / BM; nwg = 8 * X.nbx * nN; nt = nt_; ak = ak_; bk = bk_; }
    __device__ __forceinline__ bool next(int i, Unit& u) const {
        const int t = i * X.cnt + X.r; if (t >= nwg) return false;
        const int nig = WGM * nN, gid = t / nig, q = t - gid * nig, pml = gid * WGM + (q & 7);
        u.pn = q >> 3; u.pm = (X.xi + (pml >> 3) * X.nx) * 8 + (pml & 7); u.ak = ak; u.bk = bk; u.nt = nt; u.kind = 0; return true;
    }
};
struct MergeOrder {
    XInfo X; int nwg;
    __device__ void init(const XInfo& X_) { X = X_; nwg = 8 * X.nbx * 4; }
    __device__ __forceinline__ bool next(int i, Unit& u) const {
        const int ti = i / 6, st = i - ti * 6, t = ti * X.cnt + X.r; if (t >= nwg) return false;
        const int nig = WGM * 4, gid = t / nig, q = t - gid * nig, pml = gid * WGM + (q & 7), n = st >> 1;
        u.pn = q >> 3; u.pm = (X.xi + (pml >> 3) * X.nx) * 8 + (pml & 7);
        if ((st & 1) == 0) { u.ak = 0; u.bk = n * 1024; u.nt = 16; } else { u.ak = 1024 + n * 512; u.bk = 3072 + n * 512; u.nt = 8; }
        u.kind = st; return true;
    }
};

struct EpiIn {
    static constexpr bool PERM = true;
    bf16_t* O;
    __device__ __forceinline__ void operator()(const f32x4 (&acc)[2][2][4][2], const Unit& u, int wr, int wc, int fr, int fq) const {
        const int row0 = u.pm * BM + wr * 64 + fr, col0 = u.pn * BM + wc * 32 + 8 * fq;
        const int mode = u.pn < 4 ? 1 : (u.pn < 6 ? 2 : 0);
#pragma unroll
        for (int ai = 0; ai < 2; ++ai)
#pragma unroll
            for (int m = 0; m < 4; ++m) { bf16_t* rowp = O + (size_t)(row0 + ai * HALF + m * 16) * MID_LD + col0;
#pragma unroll
                for (int bj = 0; bj < 2; ++bj) { f32x4 v0 = acc[ai][bj][m][0], v1 = acc[ai][bj][m][1];
                    if (mode == 1) {
#pragma unroll
                        for (int e = 0; e < 4; ++e) { v0[e] = gelu_tanh(v0[e]); v1[e] = gelu_tanh(v1[e]); }
                    } else if (mode == 2) { v0 = v0 * 0.125f; v1 = v1 * 0.125f; }
                    u32x4 w; w.x = pk2(v0[0], v0[1]); w.y = pk2(v0[2], v0[3]); w.z = pk2(v1[0], v1[1]); w.w = pk2(v1[2], v1[3]);
                    *(u32x4*)(rowp + bj * HALF) = w; } }
    }
};
struct EpiRes {
    static constexpr bool PERM = false;
    const float* xs; float* out; const float* gate;
    __device__ __forceinline__ void operator()(const f32x4 (&acc)[2][2][4][2], const Unit& u, int wr, int wc, int fr, int fq) const {
        const int row0 = u.pm * BM + wr * 64 + fr, col0 = u.pn * BM + wc * 32 + 4 * fq;
        const float* gp = gate + (size_t)(u.pm >> 3) * NMOD + col0;
        f32x4 gv[2][2];
#pragma unroll
        for (int bj = 0; bj < 2; ++bj)
#pragma unroll
            for (int n = 0; n < 2; ++n) gv[bj][n] = *(const f32x4*)(gp + bj * HALF + n * 16);
#pragma unroll
        for (int ai = 0; ai < 2; ++ai)
#pragma unroll
            for (int m = 0; m < 4; ++m) { const size_t off = (size_t)(row0 + ai * HALF + m * 16) * DM + col0;
#pragma unroll
                for (int bj = 0; bj < 2; ++bj)
#pragma unroll
                    for (int n = 0; n < 2; ++n) { const f32x4 xv = *(const f32x4*)(xs + off + bj * HALF + n * 16);
                        *(f32x4*)(out + off + bj * HALF + n * 16) = xv + gv[bj][n] * acc[ai][bj][m][n]; }
                if (m & 1) asm volatile("" ::: "memory"); }
    }
};
struct EpiFfn {
    static constexpr bool PERM = true;
    bf16_t* O;
    __device__ __forceinline__ void operator()(const f32x4 (&acc)[2][2][4][2], const Unit& u, int wr, int wc, int fr, int fq) const {
        const int row0 = u.pm * BM + wr * 64 + fr, col0 = u.pn * HALF + wc * 32 + 8 * fq;
#pragma unroll
        for (int ai = 0; ai < 2; ++ai)
#pragma unroll
            for (int m = 0; m < 4; ++m) { bf16_t* rowp = O + (size_t)(row0 + ai * HALF + m * 16) * MID_LD + col0;
                f32x4 r[2];
#pragma unroll
                for (int n = 0; n < 2; ++n) { const f32x4 g = acc[ai][0][m][n], up = acc[ai][1][m][n];
#pragma unroll
                    for (int e = 0; e < 4; ++e) r[n][e] = g[e] * fast_sigmoid(g[e]) * up[e]; }
                u32x4 w; w.x = pk2(r[0][0], r[0][1]); w.y = pk2(r[0][2], r[0][3]); w.z = pk2(r[1][0], r[1][1]); w.w = pk2(r[1][2], r[1][3]);
                *(u32x4*)rowp = w; }
    }
};
struct EpiMerge {
    static constexpr bool PERM = true;
    u32x4* gs; f32x4* ms; bf16_t* O;
    __device__ __forceinline__ void operator()(const f32x4 (&acc)[2][2][4][2], const Unit& u, int wr, int wc, int fr, int fq) const {
        const int tid = opaque_tid(), kind = u.kind;
        if ((kind & 1) == 0) {
#pragma unroll
            for (int ai = 0; ai < 2; ++ai)
#pragma unroll
                for (int bj = 0; bj < 2; ++bj)
#pragma unroll
                    for (int m = 0; m < 4; ++m) { const int j = (ai * 2 + bj) * 4 + m; f32x4 v0 = acc[ai][bj][m][0], v1 = acc[ai][bj][m][1];
#pragma unroll
                        for (int e = 0; e < 4; ++e) { v0[e] = fast_sigmoid(v0[e]); v1[e] = fast_sigmoid(v1[e]); }
                        u32x4 w; w.x = pk2(v0[0], v0[1]); w.y = pk2(v0[2], v0[3]); w.z = pk2(v1[0], v1[1]); w.w = pk2(v1[2], v1[3]);
                        gs[j * 512 + tid] = w; }
        } else {
            const int row0 = u.pm * BM + wr * 64 + fr, col0 = u.pn * BM + wc * 32 + 8 * fq;
#pragma unroll
            for (int ai = 0; ai < 2; ++ai)
#pragma unroll
                for (int bj = 0; bj < 2; ++bj) {
#pragma unroll
                    for (int m = 0; m < 4; ++m) { const int j = (ai * 2 + bj) * 4 + m; const u32x4 gw = gs[j * 512 + tid];
                        f32x4 p0 = acc[ai][bj][m][0], p1 = acc[ai][bj][m][1];
                        p0[0] *= bflo(gw.x); p0[1] *= bfhi(gw.x); p0[2] *= bflo(gw.y); p0[3] *= bfhi(gw.y);
                        p1[0] *= bflo(gw.z); p1[1] *= bfhi(gw.z); p1[2] *= bflo(gw.w); p1[3] *= bfhi(gw.w);
                        if (kind != 1) { p0 += ms[(2 * j) * 512 + tid]; p1 += ms[(2 * j + 1) * 512 + tid]; }
                        if (kind != 5) { ms[(2 * j) * 512 + tid] = p0; ms[(2 * j + 1) * 512 + tid] = p1; }
                        else { u32x4 w; w.x = pk2(p0[0], p0[1]); w.y = pk2(p0[2], p0[3]); w.z = pk2(p1[0], p1[1]); w.w = pk2(p1[2], p1[3]);
                            *(u32x4*)(O + (size_t)(row0 + ai * HALF + m * 16) * DM + col0 + bj * HALF) = w; }
                        if (m & 1) asm volatile("" ::: "memory"); } }
        }
    }
};

template <class Epi, class Sched, bool ALIGN_EPI = true>
__device__ __forceinline__ void gemm_phase(LAS unsigned char* lds, const Gemm g, const Sched& S, const Epi& E) {
    const int tid = opaque_tid(), wid = __builtin_amdgcn_readfirstlane(tid >> 6), lane = tid & 63, wr = wid >> 2, wc = wid & 3, fr = lane & 15, fq = lane >> 4;
    unsigned voffA[2], voffB[2];
#pragma unroll
    for (int i = 0; i < 2; ++i) { int R, C; stage_rc(tid * 16 + i * 8192, R, C); const int Rb = Epi::PERM ? ((R & ~31) + perm32(R & 31)) : R;
        voffA[i] = (unsigned)(R * g.lda + C) * 2u; voffB[i] = (unsigned)(Rb * g.ldb + C) * 2u; }
    const size_t kstep = (size_t)(BK * 2);
    const size_t hstepA = (size_t)HALF * g.lda * 2, hstepB = (size_t)HALF * g.ldb * 2;
    const size_t tstepA = 2 * hstepA, tstepB = 2 * hstepB;
    const unsigned ldsw = (unsigned)wid * 1024u;
    const int aoff = lds_byte(wr * 64 + fr, fq * 8), boff = lds_byte(wc * 32 + fr, fq * 8);
#define PG8_SA(b, h) (((b) * 2 + (h)) * HTB)
#define PG8_SB(b, h) ((4 + (b) * 2 + (h)) * HTB)
#define PG8_STAGE(bufoff, gbase, voff) do { _Pragma("unroll") for (int _i = 0; _i < 2; ++_i) \
        __builtin_amdgcn_global_load_lds((const unsigned*)((const char*)(gbase) + (voff)[_i]), (LAS unsigned*)(lds + (bufoff) + ldsw + _i * 8192), 16, 0, 0); } while (0)
#define PG8_LDA(dst, b, h) do { _Pragma("unroll") for (int m = 0; m < 4; ++m) _Pragma("unroll") for (int k = 0; k < 2; ++k) dst[m][k] = *(const LAS bf16x8*)(lds + PG8_SA(b, h) + aoff + m * 2048 + k * 1024); } while (0)
#define PG8_LDB(dst, b, h) do { _Pragma("unroll") for (int n = 0; n < 2; ++n) _Pragma("unroll") for (int k = 0; k < 2; ++k) dst[n][k] = *(const LAS bf16x8*)(lds + PG8_SB(b, h) + boff + n * 2048 + k * 1024); } while (0)
#define PG8_MMA(ai, bj, At, Bt) do { __builtin_amdgcn_s_setprio(1); _Pragma("unroll") for (int m = 0; m < 4; ++m) _Pragma("unroll") for (int n = 0; n < 2; ++n) _Pragma("unroll") for (int k = 0; k < 2; ++k) \
        acc[ai][bj][m][n] = __builtin_amdgcn_mfma_f32_16x16x32_bf16(Bt[n][k], At[m][k], acc[ai][bj][m][n], 0, 0, 0); __builtin_amdgcn_s_setprio(0); } while (0)
#define PG8_WAIT_V(n) asm volatile("s_waitcnt vmcnt(" #n ")" ::: "memory")
#define PG8_WAIT_L(n) asm volatile("s_waitcnt lgkmcnt(" #n ")" ::: "memory")
#define PG8_BAR __builtin_amdgcn_s_barrier()
#define PG8_SCHED __builtin_amdgcn_sched_barrier(0)
    Unit cur, nxt; int ui = 0;
    if (!S.next(0, cur)) return;
    f32x4 acc[2][2][4][2];
#pragma unroll
    for (int a = 0; a < 2; ++a)
#pragma unroll
        for (int b = 0; b < 2; ++b)
#pragma unroll
            for (int m = 0; m < 4; ++m)
#pragma unroll
                for (int n = 0; n < 2; ++n) acc[a][b][m][n] = (f32x4){0.f, 0.f, 0.f, 0.f};
    bf16x8 At[4][2], B0[2][2], B1[2][2];
    const char* cA = (const char*)g.A + (size_t)cur.pm * tstepA + (size_t)cur.ak * 2; const char* cB = (const char*)g.Bt + (size_t)cur.pn * tstepB + (size_t)cur.bk * 2;
    PG8_STAGE(PG8_SB(0, 0), cB, voffB); PG8_STAGE(PG8_SB(0, 1), cB + hstepB, voffB); PG8_STAGE(PG8_SA(0, 0), cA, voffA); PG8_STAGE(PG8_SA(0, 1), cA + hstepA, voffA);
    if (wr == 1) PG8_BAR;
    PG8_WAIT_V(2); PG8_BAR;
    PG8_STAGE(PG8_SB(1, 0), cB + kstep, voffB); PG8_STAGE(PG8_SA(1, 0), cA + kstep, voffA); PG8_STAGE(PG8_SB(1, 1), cB + hstepB + kstep, voffB);
    PG8_WAIT_V(6); PG8_BAR;
    for (;;) {
        const bool has_next = S.next(ui + 1, nxt);
        const char* nA = has_next ? (const char*)g.A + (size_t)nxt.pm * tstepA + (size_t)nxt.ak * 2 : cA;
        const char* nB = has_next ? (const char*)g.Bt + (size_t)nxt.pn * tstepB + (size_t)nxt.bk * 2 : cB;
        const int nt = cur.nt;
        for (int t = 0; t < nt; t += 2) {
            const bool last = (t == nt - 2);
            const char* a1 = cA + (size_t)(t + 1) * kstep;
            const char* a2 = last ? nA : cA + (size_t)(t + 2) * kstep; const char* b2 = last ? nB : cB + (size_t)(t + 2) * kstep;
            const char* a3 = a2 + kstep; const char* b3 = b2 + kstep;
            PG8_LDB(B0, 0, 0); PG8_LDB(B1, 0, 1); PG8_SCHED; PG8_LDA(At, 0, 0); PG8_STAGE(PG8_SA(1, 1), a1 + hstepA, voffA);
            PG8_WAIT_V(8); PG8_WAIT_L(0); PG8_BAR; PG8_MMA(0, 0, At, B0); PG8_MMA(0, 1, At, B1); PG8_BAR; PG8_SCHED;
            PG8_LDA(At, 0, 1); PG8_STAGE(PG8_SB(0, 0), b2, voffB); PG8_STAGE(PG8_SB(0, 1), b2 + hstepB, voffB); PG8_STAGE(PG8_SA(0, 0), a2, voffA);
            PG8_WAIT_V(8); PG8_WAIT_L(0); PG8_BAR; PG8_MMA(1, 0, At, B0); PG8_MMA(1, 1, At, B1); PG8_BAR; PG8_SCHED;
            PG8_LDB(B0, 1, 0); PG8_LDB(B1, 1, 1); PG8_SCHED; PG8_LDA(At, 1, 0); PG8_STAGE(PG8_SA(0, 1), a2 + hstepA, voffA);
            PG8_WAIT_V(8); PG8_WAIT_L(0); PG8_BAR; PG8_MMA(0, 0, At, B0); PG8_MMA(0, 1, At, B1); PG8_BAR; PG8_SCHED;
            PG8_LDA(At, 1, 1); PG8_STAGE(PG8_SB(1, 0), b3, voffB); PG8_STAGE(PG8_SB(1, 1), b3 + hstepB, voffB); PG8_STAGE(PG8_SA(1, 0), a3, voffA);
            PG8_WAIT_V(8); PG8_WAIT_L(0); PG8_BAR; PG8_MMA(1, 0, At, B0); PG8_MMA(1, 1, At, B1); PG8_BAR; PG8_SCHED;
        }
        if constexpr (ALIGN_EPI) { if (wr == 0) PG8_BAR; }
        E(acc, cur, wr, wc, fr, fq);
        if (!has_next) break;
#pragma unroll
        for (int a = 0; a < 2; ++a)
#pragma unroll
            for (int b = 0; b < 2; ++b)
#pragma unroll
                for (int m = 0; m < 4; ++m)
#pragma unroll
                    for (int n = 0; n < 2; ++n) acc[a][b][m][n] = (f32x4){0.f, 0.f, 0.f, 0.f};
        cur = nxt; cA = nA; cB = nB; ++ui;
        if constexpr (ALIGN_EPI) { if (wr == 1) PG8_BAR; }
    }
    PG8_WAIT_V(0);
    if constexpr (!ALIGN_EPI) { if (wr == 0) PG8_BAR; }
    PG8_BAR;
#undef PG8_SA
#undef PG8_SB
#undef PG8_STAGE
#undef PG8_LDA
#undef PG8_LDB
#undef PG8_MMA
#undef PG8_WAIT_V
#undef PG8_WAIT_L
#undef PG8_BAR
#undef PG8_SCHED
}
}

struct Params { const float* in[18]; float* out; unsigned char* ws; int ph_lo, ph_hi, coop, pad; };
enum { I_X = 0, I_C, I_G1, I_G2, I_WADA, I_BADA, I_WIN, I_LNG, I_LNB, I_WSP, I_BSP, I_PW, I_PS, I_WBR, I_WOUT, I_WFI, I_WFO, I_FG };

#define MFMA32(a, b, c) __builtin_amdgcn_mfma_f32_32x32x16_bf16(a, b, c, 0, 0, 0)
typedef short v4i16_t __attribute__((ext_vector_type(4)));
__device__ __forceinline__ s16x4 tr_read(LAS const unsigned char* p) { return __builtin_bit_cast(s16x4, __builtin_amdgcn_ds_read_tr16_b64_v4i16((LAS v4i16_t*)p)); }
__device__ __forceinline__ bf16x8 cat8(s16x4 a, s16x4 b) { bf16x8 r; r[0] = a[0]; r[1] = a[1]; r[2] = a[2]; r[3] = a[3]; r[4] = b[0]; r[5] = b[1]; r[6] = b[2]; r[7] = b[3]; return r; }

__device__ __forceinline__ void transpose_tile(LAS float* tl, const float* src, int ld, bf16_t* dst, int ldd) {
    const int tid = opaque_tid();
    { const int r = tid >> 4, c4 = (tid & 15) * 4;
#pragma unroll
      for (int h = 0; h < 2; ++h) { const int k = r + 32 * h; const f32x4 v = *(const f32x4*)(src + (size_t)k * ld + c4);
          tl[k * 65 + c4] = v[0]; tl[k * 65 + c4 + 1] = v[1]; tl[k * 65 + c4 + 2] = v[2]; tl[k * 65 + c4 + 3] = v[3]; } }
    __syncthreads();
    { const int n = tid >> 3, k8 = (tid & 7) * 8; float v[8];
#pragma unroll
      for (int j = 0; j < 8; ++j) v[j] = tl[(k8 + j) * 65 + n];
      u32x4 w; w.x = pk2(v[0], v[1]); w.y = pk2(v[2], v[3]); w.z = pk2(v[4], v[5]); w.w = pk2(v[6], v[7]);
      *(u32x4*)(dst + (size_t)n * ldd + k8) = w; }
    __syncthreads();
}

__device__ __forceinline__ void p0_prologue(const Params& p, LAS unsigned char* lds) {
    const int tid = opaque_tid(), G = gridDim.x, bid = blockIdx.x;
    unsigned char* ws = p.ws;
    bf16_t* WIN = (bf16_t*)(ws + WS_WIN); bf16_t* WMG = (bf16_t*)(ws + WS_WMG); bf16_t* WOUT = (bf16_t*)(ws + WS_WOUT);
    bf16_t* WFI = (bf16_t*)(ws + WS_WFI); bf16_t* WFO = (bf16_t*)(ws + WS_WFO); bf16_t* WPT = (bf16_t*)(ws + WS_WPT); bf16_t* WSP = (bf16_t*)(ws + WS_WSP);
    LAS float* tl = (LAS float*)lds;
    constexpr int TPL = 4304;
    for (int J = bid; J < NL * TPL; J += G) {
        const int l = J / TPL; int j = J - l * TPL;
        const float* src; int ld; bf16_t* dst; int ldd;
        if (j < 768) { const int kt = j / 48, ntile = j % 48;
            src = p.in[I_WIN] + ((size_t)l * DM + kt * 64) * 6144 + ntile * 64; ld = 6144; dst = WIN + ((size_t)l * 3072 + ntile * 64) * DM + kt * 64; ldd = DM; }
        else if (j < 1536) { j -= 768; const int kt = j / 48, ntile = j % 48, br = ntile >> 4, n0 = (ntile & 15) * 64;
            src = p.in[I_WIN] + ((size_t)l * DM + kt * 64) * 6144 + 3072 + ntile * 64; ld = 6144; dst = WMG + ((size_t)l * DM + n0) * WMG_LD + br * 1024 + kt * 64; ldd = WMG_LD; }
        else if (j < 1920) { j -= 1536; const int br = j >> 7, r = j & 127, kt = r >> 4, ntile = r & 15;
            src = p.in[I_WBR] + ((size_t)(l * 3 + br) * BW + kt * 64) * DM + ntile * 64; ld = DM; dst = WMG + ((size_t)l * DM + ntile * 64) * WMG_LD + 3072 + br * 512 + kt * 64; ldd = WMG_LD; }
        else if (j < 2176) { j -= 1920; const int kt = j >> 4, ntile = j & 15;
            src = p.in[I_WOUT] + ((size_t)l * DM + kt * 64) * DM + ntile * 64; ld = DM; dst = WOUT + ((size_t)l * DM + ntile * 64) * DM + kt * 64; ldd = DM; }
        else if (j < 3584) { j -= 2176; const int kt = j / 88, ntile = j % 88, c0 = ntile * 64; const bool up = c0 >= FF; const int f0 = up ? c0 - FF : c0;
            const int np = 256 * (f0 >> 7) + (f0 & 127) + (up ? 128 : 0);
            src = p.in[I_WFI] + ((size_t)l * DM + kt * 64) * (2 * FF) + c0; ld = 2 * FF; dst = WFI + ((size_t)l * (2 * FF) + np) * DM + kt * 64; ldd = DM; }
        else if (j < 4288) { j -= 3584; const int kt = j >> 4, ntile = j & 15;
            src = p.in[I_WFO] + ((size_t)l * FF + kt * 64) * DM + ntile * 64; ld = DM; dst = WFO + ((size_t)l * DM + ntile * 64) * FF + kt * 64; ldd = FF; }
        else { j -= 4288; const int gg = j >> 2, r = j & 3, kt = r >> 1, ntile = r & 1;
            src = p.in[I_PW] + ((size_t)(l * 4 + gg) * 128 + kt * 64) * 128 + ntile * 64; ld = 128; dst = WPT + ((size_t)(l * 4 + gg) * 128 + ntile * 64) * 128 + kt * 64; ldd = 128; }
        transpose_tile(tl, src, ld, dst, ldd);
    }
    for (int idx = bid * 512 + tid; idx < NL * 4 * 128 * 128; idx += G * 512) { const int t = (idx >> 7) & 127, s = idx & 127; WSP[idx] = (s <= t) ? (bf16_t)f2bf(p.in[I_WSP][idx]) : (bf16_t)0; }
    LAS float* ca = (LAS float*)lds;
    float* MOD = (float*)(ws + WS_MOD);
    for (int cgp = bid; cgp < (NL * NMOD) / 96; cgp += G) {
        __syncthreads();
        for (int i = tid; i < NB * DM; i += 512) { const int b = i >> 10, k = i & 1023; const float cv = p.in[I_C][i]; ca[k * 32 + b] = cv * fast_sigmoid(cv); }
        __syncthreads();
        const int cj = tid & 31, ks = tid >> 5;
        float acc[3][32];
#pragma unroll
        for (int q = 0; q < 3; ++q)
#pragma unroll
            for (int b = 0; b < 32; ++b) acc[q][b] = 0.f;
        const int colg = cgp * 96;
        const int l = colg / NMOD, cl = colg - l * NMOD;
        const float* wa = p.in[I_WADA] + (size_t)l * DM * NMOD + cl + cj;
        for (int k = ks * 64; k < ks * 64 + 64; ++k) {
            float w[3];
#pragma unroll
            for (int q = 0; q < 3; ++q) w[q] = wa[(size_t)k * NMOD + q * 32];
            f32x4 cv[8];
#pragma unroll
            for (int i = 0; i < 8; ++i) cv[i] = *(const LAS f32x4*)(ca + k * 32 + i * 4);
#pragma unroll
            for (int q = 0; q < 3; ++q)
#pragma unroll
                for (int b = 0; b < 32; ++b) acc[q][b] += cv[b >> 2][b & 3] * w[q];
        }
        LAS float* red = (LAS float*)lds;
#pragma unroll
        for (int q = 0; q < 3; ++q) {
            __syncthreads();
#pragma unroll
            for (int b = 0; b < 32; ++b) red[(ks * 32 + b) * 32 + cj] = acc[q][b];
            __syncthreads();
            for (int o = tid; o < 1024; o += 512) { const int b = o >> 5, c = o & 31; float s = 0.f;
#pragma unroll
                for (int k2 = 0; k2 < 16; ++k2) s += red[(k2 * 32 + b) * 32 + c];
                const int col = cl + q * 32 + c;
                MOD[((size_t)l * NB + b) * NMOD + col] = s + p.in[I_BADA][(size_t)l * NMOD + col]; }
        }
    }
    __syncthreads();
}

__device__ __forceinline__ void norm_phase(const pg8::XInfo& X, const float* xs, const float* g, const float* modl, int shoff, int scoff, bf16_t* act) {
    const int tid_ = opaque_tid(), lane = tid_ & 63, wid = tid_ >> 6;
    for (int blk = X.r * 8 + wid; blk < X.nbx * 64; blk += X.cnt * 8) {
        const int b = X.xi + (blk >> 6) * X.nx, row0 = b * SEQ + (blk & 63) * 32;
        f32x4 ga[4], sh[4];
#pragma unroll
        for (int j = 0; j < 4; ++j) { const int col = j * 256 + lane * 4; const f32x4 gv = *(const f32x4*)(g + col), sc = *(const f32x4*)(modl + (size_t)b * NMOD + scoff + col);
            ga[j] = gv * (1.0f + sc); sh[j] = *(const f32x4*)(modl + (size_t)b * NMOD + shoff + col); }
#pragma unroll 2
        for (int r = 0; r < 32; ++r) {
            const float* xr = xs + (size_t)(row0 + r) * DM + lane * 4;
            f32x4 x[4]; float ss = 0.f;
#pragma unroll
            for (int j = 0; j < 4; ++j) { x[j] = *(const f32x4*)(xr + j * 256); ss += x[j][0] * x[j][0] + x[j][1] * x[j][1] + x[j][2] * x[j][2] + x[j][3] * x[j][3]; }
            ss = wave_sum(ss, lane);
            const float rstd = 1.0f / sqrtf(ss * (1.0f / DM) + EPS);
            bf16_t* orow = act + (size_t)(row0 + r) * ACT_LD + lane * 4;
#pragma unroll
            for (int j = 0; j < 4; ++j) { const f32x4 y = x[j] * rstd * ga[j] + sh[j]; u32x2 w; w.x = pk2(y[0], y[1]); w.y = pk2(y[2], y[3]); *(u32x2*)(orow + j * 256) = w; }
        }
    }
}
__device__ __forceinline__ void final_norm(const pg8::XInfo& X, float* x, const float* g) {
    const int tid_ = opaque_tid(), lane = tid_ & 63, wid = tid_ >> 6;
    f32x4 gv[4];
#pragma unroll
    for (int j = 0; j < 4; ++j) gv[j] = *(const f32x4*)(g + j * 256 + lane * 4);
    for (int rl = X.r * 8 + wid; rl < X.nbx * SEQ; rl += X.cnt * 8) {
        const int row = (X.xi + (rl >> 11) * X.nx) * SEQ + (rl & 2047);
        float* xr = x + (size_t)row * DM + lane * 4;
        f32x4 v[4]; float ss = 0.f;
#pragma unroll
        for (int j = 0; j < 4; ++j) { v[j] = *(const f32x4*)(xr + j * 256); ss += v[j][0] * v[j][0] + v[j][1] * v[j][1] + v[j][2] * v[j][2] + v[j][3] * v[j][3]; }
        ss = wave_sum(ss, lane);
        const float rstd = 1.0f / sqrtf(ss * (1.0f / DM) + EPS);
#pragma unroll
        for (int j = 0; j < 4; ++j) *(f32x4*)(xr + j * 256) = v[j] * rstd * gv[j];
    }
}

__device__ __forceinline__ void gmlp_unit(LAS unsigned char* lds, int b, int ch, const bf16_t* mid, const bf16_t* wsp, const float* lng, const float* lnb, const float* bsp, bf16_t* act) {
    const int tid = opaque_tid(), lane = tid & 63, wid = tid >> 6;
    const int row0 = b * SEQ + ch * 128;
    {
        const int s = tid >> 2, q = tid & 3;
        const bf16_t* vp = mid + (size_t)(row0 + s) * MID_LD + 512 + q * 8;
        float sum = 0.f, sq = 0.f;
#pragma unroll 4
        for (int i = 0; i < 16; ++i) { const u32x4 v = *(const u32x4*)(vp + i * 32);
            const float a0 = bflo(v.x), a1 = bfhi(v.x), a2 = bflo(v.y), a3 = bfhi(v.y), a4 = bflo(v.z), a5 = bfhi(v.z), a6 = bflo(v.w), a7 = bfhi(v.w);
            sum += ((a0 + a1) + (a2 + a3)) + ((a4 + a5) + (a6 + a7));
            sq += ((a0 * a0 + a1 * a1) + (a2 * a2 + a3 * a3)) + ((a4 * a4 + a5 * a5) + (a6 * a6 + a7 * a7)); }
        sum += shx(sum, lane, 1); sum += shx(sum, lane, 2);
        sq += shx(sq, lane, 1); sq += shx(sq, lane, 2);
        const float mean = sum * (1.0f / BW);
        const float var = fmaxf(sq * (1.0f / BW) - mean * mean, 0.f);
        const float rstd = 1.0f / sqrtf(var + EPS);
#pragma unroll 2
        for (int i = 0; i < 16; ++i) {
            const int c = (4 * i + q) * 8;
            const u32x4 v = *(const u32x4*)(vp + i * 32);
            const f32x4 g0 = *(const f32x4*)(lng + c), g1 = *(const f32x4*)(lng + c + 4), b0 = *(const f32x4*)(lnb + c), b1 = *(const f32x4*)(lnb + c + 4);
            u32x4 w;
            w.x = pk2((bflo(v.x) - mean) * rstd * g0[0] + b0[0], (bfhi(v.x) - mean) * rstd * g0[1] + b0[1]);
            w.y = pk2((bflo(v.y) - mean) * rstd * g0[2] + b0[2], (bfhi(v.y) - mean) * rstd * g0[3] + b0[3]);
            w.z = pk2((bflo(v.z) - mean) * rstd * g1[0] + b1[0], (bfhi(v.z) - mean) * rstd * g1[1] + b1[1]);
            w.w = pk2((bflo(v.w) - mean) * rstd * g1[2] + b1[2], (bfhi(v.w) - mean) * rstd * g1[3] + b1[3]);
            *(LAS u32x4*)(lds + i * 8192 + s * 64 + q * 16) = w;
        }
    }
    __syncthreads();
    {
        const int g = wid >> 1, hh = lane >> 5, l32 = lane & 31, i16 = lane & 15, g16 = lane >> 4;
        const unsigned troff = (unsigned)((4 * hh + (i16 >> 2)) * 64 + (16 * (g16 & 1) + 4 * (i16 & 3)) * 2);
#pragma unroll 1
        for (int nti = 0; nti < 2; ++nti) {
            const int nt = (wid & 1) ? (1 + nti) : (nti * 3);
            f32x16 acc[4];
#pragma unroll
            for (int mt = 0; mt < 4; ++mt)
#pragma unroll
                for (int e = 0; e < 16; ++e) acc[mt][e] = 0.f;
            const bf16_t* wrow = wsp + (size_t)(g * 128 + nt * 32 + l32) * 128 + 4 * hh;
            const int nkk = 2 * nt + 2;
            bf16x8 bfr[8];
#pragma unroll
            for (int kk = 0; kk < 8; ++kk) {
                u32x4 bw = {0u, 0u, 0u, 0u};
                if (kk < nkk) { const u32x2 lo = *(const u32x2*)(wrow + kk * 16), hi = *(const u32x2*)(wrow + kk * 16 + 8); bw.x = lo.x; bw.y = lo.y; bw.z = hi.x; bw.w = hi.y; }
                bfr[kk] = __builtin_bit_cast(bf16x8, bw);
            }
#pragma unroll
            for (int kk = 0; kk < 8; ++kk) {
                if (kk < nkk) {
#pragma unroll
                    for (int mt = 0; mt < 4; ++mt) {
                        LAS const unsigned char* ap = lds + (4 * g + mt) * 8192 + kk * 1024 + troff;
                        const bf16x8 afrag = cat8(tr_read(ap), tr_read(ap + 512));
                        acc[mt] = MFMA32(afrag, bfr[kk], acc[mt]);
                    }
                }
            }
            const int t = nt * 32 + l32; const size_t row = (size_t)(row0 + t);
            const float bs = bsp[g * 128 + t];
#pragma unroll
            for (int mt = 0; mt < 4; ++mt)
#pragma unroll
                for (int a = 0; a < 4; ++a) {
                    const int c0 = g * 128 + mt * 32 + a * 8 + 4 * hh;
                    const u32x2 uu = *(const u32x2*)(mid + row * MID_LD + c0);
                    u32x2 w;
                    w.x = pk2(bflo(uu.x) * (acc[mt][4 * a + 0] + bs), bfhi(uu.x) * (acc[mt][4 * a + 1] + bs));
                    w.y = pk2(bflo(uu.y) * (acc[mt][4 * a + 2] + bs), bfhi(uu.y) * (acc[mt][4 * a + 3] + bs));
                    *(u32x2*)(act + row * ACT_LD + 1024 + c0) = w;
                }
        }
    }
    __syncthreads();
}

__device__ __forceinline__ void pool_unit(LAS unsigned char* lds, int b, int tl, const bf16_t* mid, const bf16_t* wpt, const float* pscale, bf16_t* act) {
    const int tid = opaque_tid(), lane = tid & 63, wid = tid >> 6;
    const int row0 = b * SEQ + tl * 128, pos0 = tl * 128;
    const int hh = lane >> 5, l32 = lane & 31;
    LAS unsigned char* xa = lds;
    LAS unsigned char* dt = lds + 40960;
#pragma unroll 1
    for (int g = 0; g < 4; ++g) {
        const int w = 2 << g;
        for (int item = tid; item < 144 * 16; item += 512) {
            const int r = item >> 4, chn = item & 15, pos = pos0 - 16 + r;
            u32x4 v = {0u, 0u, 0u, 0u};
            if (pos >= 0) v = *(const u32x4*)(mid + (size_t)(row0 - 16 + r) * MID_LD + 2560 + g * 128 + chn * 8);
            *(LAS u32x4*)(xa + r * 272 + chn * 16) = v;
        }
        __syncthreads();
#pragma unroll 1
        for (int it = 0; it < 4; ++it) {
            const int item = tid + it * 512, t = item >> 4, chn = item & 15;
            const int pos = pos0 + t, cnt = (pos + 1 < w) ? pos + 1 : w;
            LAS const unsigned char* xp = xa + (t + 16) * 272 + chn * 16;
            const u32x4 x0 = *(const LAS u32x4*)xp;
            float a[8] = {0.f, 0.f, 0.f, 0.f, 0.f, 0.f, 0.f, 0.f};
#pragma unroll 2
            for (int j = 0; j < w; ++j) { const u32x4 xv = *(const LAS u32x4*)(xp - j * 272);
                a[0] += bflo(xv.x); a[1] += bfhi(xv.x); a[2] += bflo(xv.y); a[3] += bfhi(xv.y); a[4] += bflo(xv.z); a[5] += bfhi(xv.z); a[6] += bflo(xv.w); a[7] += bfhi(xv.w); }
            const float inv = 1.0f / (float)cnt;
            u32x4 o; o.x = pk2(a[0] * inv - bflo(x0.x), a[1] * inv - bfhi(x0.x)); o.y = pk2(a[2] * inv - bflo(x0.y), a[3] * inv - bfhi(x0.y));
            o.z = pk2(a[4] * inv - bflo(x0.z), a[5] * inv - bfhi(x0.z)); o.w = pk2(a[6] * inv - bflo(x0.w), a[7] * inv - bfhi(x0.w));
            *(LAS u32x4*)(dt + t * 272 + chn * 16) = o;
        }
        __syncthreads();
        {
            const int mt = wid & 3, nt0 = (wid >> 2) * 2;
            bf16x8 af[8];
            const bf16_t* ap = wpt + (size_t)(g * 128 + mt * 32 + l32) * 128 + 8 * hh;
#pragma unroll
            for (int kk = 0; kk < 8; ++kk) af[kk] = *(const bf16x8*)(ap + kk * 16);
#pragma unroll 1
            for (int nti = 0; nti < 2; ++nti) {
                const int nt = nt0 + nti;
                f32x16 acc;
#pragma unroll
                for (int e = 0; e < 16; ++e) acc[e] = 0.f;
                LAS const unsigned char* bp = dt + (nt * 32 + l32) * 272 + 16 * hh;
#pragma unroll
                for (int kk = 0; kk < 8; ++kk) { const bf16x8 bf = *(const LAS bf16x8*)(bp + kk * 32); acc = MFMA32(af[kk], bf, acc); }
                const size_t row = (size_t)(row0 + nt * 32 + l32);
#pragma unroll
                for (int a = 0; a < 4; ++a) { const int dd = g * 128 + mt * 32 + a * 8 + 4 * hh; const f32x4 sc = *(const f32x4*)(pscale + dd);
                    u32x2 o; o.x = pk2(acc[4 * a] * sc[0], acc[4 * a + 1] * sc[1]); o.y = pk2(acc[4 * a + 2] * sc[2], acc[4 * a + 3] * sc[3]);
                    *(u32x2*)(act + row * ACT_LD + 2048 + dd) = o; }
            }
        }
        __syncthreads();
    }
}

__device__ __forceinline__ void attn_wave(LAS unsigned char* vl, int b, int h, int qb, const bf16_t* mid, bf16_t* act, int lane) {
    const int hh = lane >> 5, ql = lane & 31, i16 = lane & 15, g16 = lane >> 4;
    const size_t rowq = (size_t)b * SEQ + qb * 32 + ql;
    bf16x8 qf[4];
#pragma unroll
    for (int kk = 0; kk < 4; ++kk) qf[kk] = *(const bf16x8*)(mid + rowq * MID_LD + 1024 + h * 64 + kk * 16 + 8 * hh);
    f32x16 o0, o1;
#pragma unroll
    for (int e = 0; e < 16; ++e) { o0[e] = 0.f; o1[e] = 0.f; }
    float C = 1.0f;
    const unsigned troff = (unsigned)((4 * hh + (i16 >> 2)) * 64 + (16 * (g16 & 1) + 4 * (i16 & 3)) * 2);
    const bf16_t* kbase = mid + ((size_t)b * SEQ + ql) * MID_LD + 1536 + h * 64 + 8 * hh;
    const bf16_t* vbase = mid + ((size_t)b * SEQ + ql) * MID_LD + 2048 + h * 64 + 8 * hh;
    bf16x8 kn[4]; u32x4 vn[4];
#pragma unroll
    for (int c = 0; c < 4; ++c) { kn[c] = *(const bf16x8*)(kbase + (size_t)qb * 32 * MID_LD + c * 16); vn[c] = *(const u32x4*)(vbase + (size_t)qb * 32 * MID_LD + c * 16); }
#pragma unroll 1
    for (int kt = qb; kt >= 0; --kt) {
        bf16x8 kf[4]; u32x4 vv[4];
#pragma unroll
        for (int c = 0; c < 4; ++c) { kf[c] = kn[c]; vv[c] = vn[c]; }
        if (kt > 0) {
#pragma unroll
            for (int c = 0; c < 4; ++c) { kn[c] = *(const bf16x8*)(kbase + (size_t)(kt - 1) * 32 * MID_LD + c * 16); vn[c] = *(const u32x4*)(vbase + (size_t)(kt - 1) * 32 * MID_LD + c * 16); }
        }
#pragma unroll
        for (int c = 0; c < 4; ++c) { const int chn = hh + 2 * c; *(LAS u32x4*)(vl + (chn >> 2) * 2048 + ql * 64 + (chn & 3) * 16) = vv[c]; }
        f32x16 s;
#pragma unroll
        for (int e = 0; e < 16; ++e) s[e] = 0.f;
#pragma unroll
        for (int kk = 0; kk < 4; ++kk) s = MFMA32(kf[kk], qf[kk], s);
        float bt[16], om[16];
        const bool diag = (kt == qb);
#pragma unroll
        for (int r = 0; r < 16; ++r) {
            const float e = __builtin_amdgcn_exp2f(fminf(s[r] * LOG2E, 100.0f));
            float o1 = __builtin_amdgcn_rcpf(1.0f + e), b1 = e * o1;
            const int keyl = 8 * (r >> 2) + 4 * hh + (r & 3);
            if (diag && keyl >= ql) { o1 = 1.0f; b1 = 0.0f; }
            om[r] = o1; bt[r] = b1;
        }
        float g4[4], pg[4];
#pragma unroll
        for (int a = 0; a < 4; ++a) g4[a] = (om[4 * a] * om[4 * a + 1]) * (om[4 * a + 2] * om[4 * a + 3]);
#pragma unroll
        for (int a = 0; a < 4; ++a) pg[a] = shx(g4[a], lane, 32);
        float after = 1.0f; float pa[16];
#pragma unroll
        for (int a = 3; a >= 0; --a) {
            const float s3 = C * after * (hh == 0 ? pg[a] : 1.0f), s2 = s3 * om[4 * a + 3], s1 = s2 * om[4 * a + 2], s0 = s1 * om[4 * a + 1];
            pa[4 * a + 3] = bt[4 * a + 3] * s3; pa[4 * a + 2] = bt[4 * a + 2] * s2; pa[4 * a + 1] = bt[4 * a + 1] * s1; pa[4 * a + 0] = bt[4 * a + 0] * s0;
            after *= g4[a] * pg[a];
        }
        C *= after;
#pragma unroll
        for (int kk2 = 0; kk2 < 2; ++kk2) {
            u32x4 pw; pw.x = pk2(pa[8 * kk2 + 0], pa[8 * kk2 + 1]); pw.y = pk2(pa[8 * kk2 + 2], pa[8 * kk2 + 3]); pw.z = pk2(pa[8 * kk2 + 4], pa[8 * kk2 + 5]); pw.w = pk2(pa[8 * kk2 + 6], pa[8 * kk2 + 7]);
            const bf16x8 pf = __builtin_bit_cast(bf16x8, pw);
            LAS const unsigned char* ap = vl + kk2 * 1024 + troff;
            const bf16x8 a0 = cat8(tr_read(ap), tr_read(ap + 512));
            const bf16x8 a1 = cat8(tr_read(ap + 2048), tr_read(ap + 2048 + 512));
            o0 = MFMA32(a0, pf, o0); o1 = MFMA32(a1, pf, o1);
        }
        if (__all(C < 1.0e-38f)) break;
    }
    bf16_t* op = act + rowq * ACT_LD + 1536 + h * 64 + 4 * hh;
#pragma unroll
    for (int a = 0; a < 4; ++a) {
        u32x2 w0, w1; w0.x = pk2(o0[4 * a], o0[4 * a + 1]); w0.y = pk2(o0[4 * a + 2], o0[4 * a + 3]); w1.x = pk2(o1[4 * a], o1[4 * a + 1]); w1.y = pk2(o1[4 * a + 2], o1[4 * a + 3]);
        *(u32x2*)(op + a * 8) = w0; *(u32x2*)(op + 32 + a * 8) = w1;
    }
}


__global__ void __launch_bounds__(512, 2) fwd_megakernel(Params p) {
    extern __shared__ __attribute__((aligned(16))) unsigned char lds_raw[];
    LAS unsigned char* lds = (LAS unsigned char*)lds_raw;
    cg::grid_group grid = cg::this_grid();
    unsigned* const gbar = (unsigned*)p.ws; unsigned gtarget = 0;
#define GSYNC() do { asm volatile("s_waitcnt vmcnt(0) lgkmcnt(0)" ::: "memory"); __syncthreads(); gtarget = (unsigned)__builtin_amdgcn_readfirstlane((int)(gtarget + gridDim.x)); \
        if (threadIdx.x == 0) { __builtin_amdgcn_fence(__ATOMIC_RELEASE, "agent"); asm volatile("s_waitcnt vmcnt(0)" ::: "memory"); \
            __hip_atomic_fetch_add(gbar, 1u, __ATOMIC_RELAXED, __HIP_MEMORY_SCOPE_AGENT); \
            while (__hip_atomic_load(gbar, __ATOMIC_RELAXED, __HIP_MEMORY_SCOPE_AGENT) < gtarget) __builtin_amdgcn_s_sleep(2); } \
        __syncthreads(); __builtin_amdgcn_fence(__ATOMIC_ACQUIRE, "agent"); asm volatile("s_waitcnt vmcnt(0)" ::: "memory"); } while (0)
    unsigned xtarget = 0;
#define XSYNC() do { asm volatile("s_waitcnt vmcnt(0) lgkmcnt(0)" ::: "memory"); __syncthreads(); xtarget = (unsigned)__builtin_amdgcn_readfirstlane((int)(xtarget + (unsigned)X.cnt)); \
        if (threadIdx.x == 0) { __hip_atomic_fetch_add(xbar, 1u, __ATOMIC_RELAXED, __HIP_MEMORY_SCOPE_AGENT); \
            while (__hip_atomic_load(xbar, __ATOMIC_RELAXED, __HIP_MEMORY_SCOPE_AGENT) < xtarget) __builtin_amdgcn_s_sleep(1); } \
        __syncthreads(); __builtin_amdgcn_fence(__ATOMIC_ACQUIRE, "agent"); asm volatile("s_waitcnt vmcnt(0)" ::: "memory"); } while (0)
    grid.sync();
    const int G = gridDim.x, bid = blockIdx.x, tid = threadIdx.x;
    typedef const Params __attribute__((address_space(4)))* KArg;
    KArg kp = (KArg)__builtin_amdgcn_kernarg_segment_ptr();

    pg8::XInfo X;
    { LAS unsigned* sh = (LAS unsigned*)(lds + 131072);
      if (tid == 0) { const unsigned xc = (unsigned)__builtin_amdgcn_s_getreg((3 << 11) | 20) & 0xFu;
          sh[0] = xc; sh[1] = __hip_atomic_fetch_add(gbar + 64 + 64 * xc, 1u, __ATOMIC_RELAXED, __HIP_MEMORY_SCOPE_AGENT); }
      __syncthreads();
      const unsigned xcc = sh[0]; X.r = (int)sh[1];
      p0_prologue(p, lds);
      GSYNC();
      int nx = 0, xi = 0, cnt = 0;
      for (unsigned j = 0; j < 16; ++j) { const unsigned cj = __hip_atomic_load(gbar + 64 + 64 * j, __ATOMIC_RELAXED, __HIP_MEMORY_SCOPE_AGENT); if (cj) { if (j == xcc) { xi = nx; cnt = (int)cj; } ++nx; } }
      X.xi = __builtin_amdgcn_readfirstlane(xi); X.nx = __builtin_amdgcn_readfirstlane(nx); X.cnt = __builtin_amdgcn_readfirstlane(cnt); X.r = __builtin_amdgcn_readfirstlane(X.r);
      X.nbx = (NB - X.xi + X.nx - 1) / X.nx; }
    unsigned* const xbar = gbar + 2048 + 64 * __builtin_amdgcn_readfirstlane((int)((LAS unsigned*)(lds + 131072))[0]);
#pragma unroll 1
    for (int l = 0; l < NL; ++l) {
        KArg q = kp; asm volatile("" : "+s"(q));
        unsigned char* ws = q->ws; float* xout = q->out;
        float* MOD = (float*)(ws + WS_MOD);
        bf16_t* WSP = (bf16_t*)(ws + WS_WSP); bf16_t* WPT = (bf16_t*)(ws + WS_WPT);
        bf16_t* WIN = (bf16_t*)(ws + WS_WIN); bf16_t* WMG = (bf16_t*)(ws + WS_WMG); bf16_t* WOUT = (bf16_t*)(ws + WS_WOUT);
        bf16_t* WFI = (bf16_t*)(ws + WS_WFI); bf16_t* WFO = (bf16_t*)(ws + WS_WFO);
        bf16_t* ACT = (bf16_t*)(ws + WS_ACT); bf16_t* MID = (bf16_t*)(ws + WS_MID); bf16_t* MRG = (bf16_t*)(ws + WS_MRG); bf16_t* FB = (bf16_t*)(ws + WS_F);
        const float* xs = (l == 0) ? q->in[I_X] : xout;
        const float* modl = MOD + (size_t)l * NB * NMOD;
        norm_phase(X, xs, q->in[I_G1] + l * DM, modl, 0, DM, ACT);
        XSYNC();
        { pg8::Gemm g{ACT, WIN + (size_t)l * 3072 * DM, ACT_LD, DM}; pg8::StaticOrder S; S.init(X, 3072, 16); pg8::EpiIn E{MID};
          pg8::gemm_phase<pg8::EpiIn, pg8::StaticOrder>(lds, g, S, E); }
        XSYNC();
        for (int u = X.r; u < X.nbx * 16; u += X.cnt)
            gmlp_unit(lds, X.xi + (u >> 4) * X.nx, u & 15, MID, WSP + (size_t)l * 4 * 128 * 128, q->in[I_LNG] + l * BW, q->in[I_LNB] + l * BW, q->in[I_BSP] + l * 4 * 128, ACT);
        for (int u = X.r; u < X.nbx * 16; u += X.cnt)
            pool_unit(lds, X.xi + (u >> 4) * X.nx, u & 15, MID, WPT + (size_t)l * 4 * 128 * 128, q->in[I_PS] + l * BW, ACT);
        { const int t2 = opaque_tid(), lane2 = t2 & 63, wid2 = t2 >> 6;
          for (int wu = X.r; wu < X.nbx * 64; wu += X.cnt) { const int unit = wu * 8 + wid2, bhl = unit >> 6;
              attn_wave(lds + wid2 * 4096, X.xi + (bhl >> 3) * X.nx, bhl & 7, unit & 63, MID, ACT, lane2); } }
        XSYNC();
        { const int sb = X.xi + (X.r >> 5) * X.nx;
          unsigned char* scr = ws + WS_SCR + (size_t)sb * SEQ * MID_LD * 2 + (size_t)(X.r & 31) * SCR_PER_WG;
          pg8::Gemm g{ACT, WMG + (size_t)l * DM * WMG_LD, ACT_LD, WMG_LD}; pg8::MergeOrder S; S.init(X);
          pg8::EpiMerge E{(u32x4*)scr, (f32x4*)(scr + 131072), MRG};
          pg8::gemm_phase<pg8::EpiMerge, pg8::MergeOrder>(lds, g, S, E); }
        XSYNC();
        { pg8::Gemm g{MRG, WOUT + (size_t)l * DM * DM, DM, DM}; pg8::StaticOrder S; S.init(X, DM, 16); pg8::EpiRes E{xs, xout, modl + 2 * DM};
          pg8::gemm_phase<pg8::EpiRes, pg8::StaticOrder>(lds, g, S, E); }
        XSYNC();
        norm_phase(X, xout, q->in[I_G2] + l * DM, modl, 3 * DM, 4 * DM, ACT);
        XSYNC();
        { pg8::Gemm g{ACT, WFI + (size_t)l * 2 * FF * DM, ACT_LD, DM}; pg8::StaticOrder S; S.init(X, 2 * FF, 16); pg8::EpiFfn E{FB};
          pg8::gemm_phase<pg8::EpiFfn, pg8::StaticOrder>(lds, g, S, E); }
        XSYNC();
        { pg8::Gemm g{FB, WFO + (size_t)l * DM * FF, MID_LD, FF}; pg8::StaticOrder S; S.init(X, DM, FF / 64); pg8::EpiRes E{xout, xout, modl + 5 * DM};
          pg8::gemm_phase<pg8::EpiRes, pg8::StaticOrder>(lds, g, S, E); }
        XSYNC();
    }
    final_norm(X, kp->out, kp->in[I_FG]);
}

extern "C" void kernel_launch(void* const* d_in, const int* in_sizes, int n_in, void* d_out, int out_size, void* d_ws, size_t ws_size, hipStream_t stream) {
    static int grid = 0;
    if (grid == 0) {
        if (n_in != 18 || in_sizes[0] != NTOK * DM || out_size != NTOK * DM || ws_size < WS_END) {
            fprintf(stderr, "kernel_launch: unexpected shapes (n_in %d, in0 %d, out %d, ws %zu, need %zu)\n", n_in, n_in > 0 ? in_sizes[0] : -1, out_size, ws_size, (size_t)WS_END); grid = -1; return; }
        int dev = 0, cus = 0, per_cu = 0;
        if (hipGetDevice(&dev) != hipSuccess || hipDeviceGetAttribute(&cus, hipDeviceAttributeMultiprocessorCount, dev) != hipSuccess) { grid = -1; return; }
        if (hipFuncSetAttribute((const void*)fwd_megakernel, hipFuncAttributeMaxDynamicSharedMemorySize, LDS_BYTES) != hipSuccess) { fprintf(stderr, "kernel_launch: hipFuncSetAttribute failed\n"); grid = -1; return; }
        if (hipOccupancyMaxActiveBlocksPerMultiprocessor(&per_cu, (const void*)fwd_megakernel, 512, LDS_BYTES) != hipSuccess || per_cu < 1) { fprintf(stderr, "kernel_launch: occupancy query gave %d\n", per_cu); per_cu = 1; }
        (void)hipGetLastError();
        grid = cus < MAX_GRID ? cus : MAX_GRID;
    }
    if (grid < 0) return;
    if (hipMemsetAsync(d_ws, 0, 16384, stream) != hipSuccess) { fprintf(stderr, "kernel_launch: memset failed\n"); return; }
    Params p{};
    for (int i = 0; i < 18; ++i) p.in[i] = (const float*)d_in[i];
    p.out = (float*)d_out; p.ws = (unsigned char*)d_ws;
    p.ph_lo = 0; p.ph_hi = 46; p.coop = 1;
    void* args[] = {&p};
    hipError_t e = hipLaunchCooperativeKernel((const void*)fwd_megakernel, dim3(grid), dim3(512), args, LDS_BYTES, stream);
    if (e != hipSuccess) fprintf(stderr, "cooperative launch failed: %s (grid %d)\n", hipGetErrorString(e), grid);
}
```

```cpp
#include <hip/hip_runtime.h>
#include <hip/hip_cooperative_groups.h>
#include <cstdio>
#include <cstdint>
namespace cg = cooperative_groups;

#define LAS __attribute__((address_space(3)))
typedef unsigned short bf16_t;
typedef short bf16x8 __attribute__((ext_vector_type(8)));
typedef short s16x4 __attribute__((ext_vector_type(4)));
typedef float f32x4 __attribute__((ext_vector_type(4)));
typedef float f32x2 __attribute__((ext_vector_type(2)));
typedef float f32x16 __attribute__((ext_vector_type(16)));
typedef unsigned u32x4 __attribute__((ext_vector_type(4)));
typedef unsigned u32x2 __attribute__((ext_vector_type(2)));

constexpr int NB = 32, SEQ = 2048, DM = 1024, NTOK = NB * SEQ, NL = 4, BW = 512, FF = 2816;
constexpr int ACT_LD = 2560;
constexpr int MID_LD = 3072;
constexpr int WMG_LD = 4608;
constexpr int NMOD = 6 * DM;
constexpr float EPS = 1e-6f;
constexpr float LOG2E = 1.4426950408889634f;

constexpr size_t MiB = (size_t)1 << 20;
constexpr size_t WS_MOD = 1 * MiB;
constexpr size_t WS_WSP = 4 * MiB;
constexpr size_t WS_WPT = 5 * MiB;
constexpr size_t WS_WIN = 6 * MiB;
constexpr size_t WS_WMG = 30 * MiB;
constexpr size_t WS_WOUT = 66 * MiB;
constexpr size_t WS_WFI = 74 * MiB;
constexpr size_t WS_WFO = 118 * MiB;
constexpr size_t WS_ACT = 140 * MiB;
constexpr size_t WS_MID = 460 * MiB;
constexpr size_t WS_SCR = 460 * MiB;
constexpr size_t SCR_PER_WG = 384 * 1024;
static_assert((size_t)SEQ * MID_LD * 2 == 32 * SCR_PER_WG, "a batch's MID block holds exactly 32 scratch slots");
constexpr size_t WS_MRG = 844 * MiB;
constexpr size_t WS_F = 460 * MiB;
constexpr size_t WS_END = 972 * MiB;
constexpr int MAX_GRID = 256;

constexpr int LDS_BYTES = 147456;

__device__ __forceinline__ unsigned f2bf(float f) { unsigned u = __builtin_bit_cast(unsigned, f); return (u + 0x7fffu + ((u >> 16) & 1u)) >> 16; }
typedef __bf16 bf16x2_t __attribute__((ext_vector_type(2)));
__device__ __forceinline__ unsigned pk2(float lo, float hi) { const f32x2 v = {lo, hi}; return __builtin_bit_cast(unsigned, __builtin_convertvector(v, bf16x2_t)); }
__device__ __forceinline__ float bflo(unsigned u) { return __builtin_bit_cast(float, u << 16); }
__device__ __forceinline__ float bfhi(unsigned u) { return __builtin_bit_cast(float, u & 0xffff0000u); }
__device__ __forceinline__ float fast_sigmoid(float x) { return __builtin_amdgcn_rcpf(1.0f + __builtin_amdgcn_exp2f(-LOG2E * x)); }
__device__ __forceinline__ float gelu_tanh(float x) {
    const float u = x * (1.0f + 0.044715f * x * x);
    return x * __builtin_amdgcn_rcpf(1.0f + __builtin_amdgcn_exp2f(-2.302208198f * u));
}
__device__ __forceinline__ int opaque_tid() { int t = threadIdx.x; asm volatile("" : "+v"(t)); return t; }
__device__ __forceinline__ float shx(float v, int lane, int o) { return __builtin_bit_cast(float, __builtin_amdgcn_ds_bpermute((lane ^ o) << 2, __builtin_bit_cast(int, v))); }
__device__ __forceinline__ float wave_sum(float v, int lane) {
#pragma unroll
    for (int o = 32; o >= 1; o >>= 1) v += shx(v, lane, o);
    return v;
}

namespace pg8 {
constexpr int BM = 256, BK = 64, HALF = 128, HTB = HALF * BK * 2, STAGE_BYTES = 8 * HTB, NXCD = 8, WGM = 8;
__host__ __device__ __forceinline__ int lds_byte(int r, int c) { const int st = (r >> 4) * 2 + (c >> 5), rr = r & 15, cc = c & 31, ob = rr * 64 + cc * 2; return st * 1024 + (ob ^ (((ob >> 9) & 1) << 5)); }
__host__ __device__ __forceinline__ void stage_rc(int b, int& R, int& C) { const int st = b / 1024, sb = b % 1024, swz = sb ^ (((sb >> 9) & 1) << 5); R = (st >> 1) * 16 + swz / 64; C = (st & 1) * 32 + (swz % 64) / 2; }
__host__ __device__ __forceinline__ int perm32(int rho) { const int n = rho >> 4, i = rho & 15; return 8 * (i >> 2) + 4 * n + (i & 3); }

struct Unit { int pm, pn, ak, bk, nt, kind; };
struct Gemm { const bf16_t* A; const bf16_t* Bt; int lda, ldb; };

__host__ __device__ __forceinline__ void tile_map(int nM, int nN, int L, int& pm, int& pn) {
    const int nwg = nM * nN; int wgid = L;
    { const int q = nwg / NXCD, r = nwg % NXCD, xcd = wgid % NXCD, off = wgid / NXCD; wgid = (xcd < r ? xcd * (q + 1) : r * (q + 1) + (xcd - r) * q) + off; }
    const int nig = WGM * nN, gid = wgid / nig, fm = gid * WGM, gsz = (nM - fm) < WGM ? (nM - fm) : WGM;
    pm = fm + ((wgid % nig) % gsz); pn = (wgid % nig) / gsz;
}
struct XInfo { int xi, nx, r, cnt, nbx; };
struct StaticOrder {
    XInfo X; int nN, nwg, nt, ak, bk;
    __device__ void init(const XInfo& X_, int N, int nt_, int ak_ = 0, int bk_ = 0) { X = X_; nN = N / BM; nwg = 8 * X.nbx * nN; nt = nt_; ak = ak_; bk = bk_; }
    __device__ __forceinline__ bool next(int i, Unit& u) const {
        const int t = i * X.cnt + X.r; if (t >= nwg) return false;
        const int nig = WGM * nN, gid = t / nig, q = t - gid * nig, pml = gid * WGM + (q & 7);
        u.pn = q >> 3; u.pm = (X.xi + (pml >> 3) * X.nx) * 8 + (pml & 7); u.ak = ak; u.bk = bk; u.nt = nt; u.kind = 0; return true;
    }
};
struct MergeOrder {
    XInfo X; int nwg;
    __device__ void init(const XInfo& X_) { X = X_; nwg = 8 * X.nbx * 4; }
    __device__ __forceinline__ bool next(int i, Unit& u) const {
        const int ti = i / 6, st = i - ti * 6, t = ti * X.cnt + X.r; if (t >= nwg) return false;
        const int nig = WGM * 4, gid = t / nig, q = t - gid * nig, pml = gid * WGM + (q & 7), n = st >> 1;
        u.pn = q >> 3; u.pm = (X.xi + (pml >> 3) * X.nx) * 8 + (pml & 7);
        if ((st & 1) == 0) { u.ak = 0; u.bk = n * 1024; u.nt = 16; } else { u.ak = 1024 + n * 512; u.bk = 3072 + n * 512; u.nt = 8; }
        u.kind = st; return true;
    }
};

struct EpiIn {
    static constexpr bool PERM = true;
    bf16_t* O;
    __device__ __forceinline__ void operator()(const f32x4 (&acc)[2][2][4][2], const Unit& u, int wr, int wc, int fr, int fq) const {
        const int row0 = u.pm * BM + wr * 64 + fr, col0 = u.pn * BM + wc * 32 + 8 * fq;
        const int mode = u.pn < 4 ? 1 : (u.pn < 6 ? 2 : 0);
#pragma unroll
        for (int ai = 0; ai < 2; ++ai)
#pragma unroll
            for (int m = 0; m < 4; ++m) { bf16_t* rowp = O + (size_t)(row0 + ai * HALF + m * 16) * MID_LD + col0;
#pragma unroll
                for (int bj = 0; bj < 2; ++bj) { f32x4 v0 = acc[ai][bj][m][0], v1 = acc[ai][bj][m][1];
                    if (mode == 1) {
#pragma unroll
                        for (int e = 0; e < 4; ++e) { v0[e] = gelu_tanh(v0[e]); v1[e] = gelu_tanh(v1[e]); }
                    } else if (mode == 2) { v0 = v0 * 0.125f; v1 = v1 * 0.125f; }
                    u32x4 w; w.x = pk2(v0[0], v0[1]); w.y = pk2(v0[2], v0[3]); w.z = pk2(v1[0], v1[1]); w.w = pk2(v1[2], v1[3]);
                    *(u32x4*)(rowp + bj * HALF) = w; } }
    }
};
struct EpiRes {
    static constexpr bool PERM = false;
    const float* xs; float* out; const float* gate;
    __device__ __forceinline__ void operator()(const f32x4 (&acc)[2][2][4][2], const Unit& u, int wr, int wc, int fr, int fq) const {
        const int row0 = u.pm * BM + wr * 64 + fr, col0 = u.pn * BM + wc * 32 + 4 * fq;
        const float* gp = gate + (size_t)(u.pm >> 3) * NMOD + col0;
        f32x4 gv[2][2];
#pragma unroll
        for (int bj = 0; bj < 2; ++bj)
#pragma unroll
            for (int n = 0; n < 2; ++n) gv[bj][n] = *(const f32x4*)(gp + bj * HALF + n * 16);
#pragma unroll
        for (int ai = 0; ai < 2; ++ai)
#pragma unroll
            for (int m = 0; m < 4; ++m) { const size_t off = (size_t)(row0 + ai * HALF + m * 16) * DM + col0;
#pragma unroll
                for (int bj = 0; bj < 2; ++bj)
#pragma unroll
                    for (int n = 0; n < 2; ++n) { const f32x4 xv = *(const f32x4*)(xs + off + bj * HALF + n * 16);
                        *(f32x4*)(out + off + bj * HALF + n * 16) = xv + gv[bj][n] * acc[ai][bj][m][n]; }
                if (m & 1) asm volatile("" ::: "memory"); }
    }
};
struct EpiFfn {
    static constexpr bool PERM = true;
    bf16_t* O;
    __device__ __forceinline__ void operator()(const f32x4 (&acc)[2][2][4][2], const Unit& u, int wr, int wc, int fr, int fq) const {
        const int row0 = u.pm * BM + wr * 64 + fr, col0 = u.pn * HALF + wc * 32 + 8 * fq;
#pragma unroll
        for (int ai = 0; ai < 2; ++ai)
#pragma unroll
            for (int m = 0; m < 4; ++m) { bf16_t* rowp = O + (size_t)(row0 + ai * HALF + m * 16) * MID_LD + col0;
                f32x4 r[2];
#pragma unroll
                for (int n = 0; n < 2; ++n) { const f32x4 g = acc[ai][0][m][n], up = acc[ai][1][m][n];
#pragma unroll
                    for (int e = 0; e < 4; ++e) r[n][e] = g[e] * fast_sigmoid(g[e]) * up[e]; }
                u32x4 w; w.x = pk2(r[0][0], r[0][1]); w.y = pk2(r[0][2], r[0][3]); w.z = pk2(r[1][0], r[1][1]); w.w = pk2(r[1][2], r[1][3]);
                *(u32x4*)rowp = w; }
    }
};
struct EpiMerge {
    static constexpr bool PERM = true;
    u32x4* gs; f32x4* ms; bf16_t* O;
    __device__ __forceinline__ void operator()(const f32x4 (&acc)[2][2][4][2], const Unit& u, int wr, int wc, int fr, int fq) const {
        const int tid = opaque_tid(), kind = u.kind;
        if ((kind & 1) == 0) {
#pragma unroll
            for (int ai = 0; ai < 2; ++ai)
#pragma unroll
                for (int bj = 0; bj < 2; ++bj)
#pragma unroll
                    for (int m = 0; m < 4; ++m) { const int j = (ai * 2 + bj) * 4 + m; f32x4 v0 = acc[ai][bj][m][0], v1 = acc[ai][bj][m][1];
#pragma unroll
                        for (int e = 0; e < 4; ++e) { v0[e] = fast_sigmoid(v0[e]); v1[e] = fast_sigmoid(v1[e]); }
                        u32x4 w; w.x = pk2(v0[0], v0[1]); w.y = pk2(v0[2], v0[3]); w.z = pk2(v1[0], v1[1]); w.w = pk2(v1[2], v1[3]);
                        gs[j * 512 + tid] = w; }
        } else {
            const int row0 = u.pm * BM + wr * 64 + fr, col0 = u.pn * BM + wc * 32 + 8 * fq;
#pragma unroll
            for (int ai = 0; ai < 2; ++ai)
#pragma unroll
                for (int bj = 0; bj < 2; ++bj) {
#pragma unroll
                    for (int m = 0; m < 4; ++m) { const int j = (ai * 2 + bj) * 4 + m; const u32x4 gw = gs[j * 512 + tid];
                        f32x4 p0 = acc[ai][bj][m][0], p1 = acc[ai][bj][m][1];
                        p0[0] *= bflo(gw.x); p0[1] *= bfhi(gw.x); p0[2] *= bflo(gw.y); p0[3] *= bfhi(gw.y);
                        p1[0] *= bflo(gw.z); p1[1] *= bfhi(gw.z); p1[2] *= bflo(gw.w); p1[3] *= bfhi(gw.w);
                        if (kind != 1) { p0 += ms[(2 * j) * 512 + tid]; p1 += ms[(2 * j + 1) * 512 + tid]; }
                        if (kind != 5) { ms[(2 * j) * 512 + tid] = p0; ms[(2 * j + 1) * 512 + tid] = p1; }
                        else { u32x4 w; w.x = pk2(p0[0], p0[1]); w.y = pk2(p0[2], p0[3]); w.z = pk2(p1[0], p1[1]); w.w = pk2(p1[2], p1[3]);
                            *(u32x4*)(O + (size_t)(row0 + ai * HALF + m * 16) * DM + col0 + bj * HALF) = w; }
                        if (m & 1) asm volatile("" ::: "memory"); } }
        }
    }
};

template <class Epi, class Sched, bool ALIGN_EPI = true>
__device__ __forceinline__ void gemm_phase(LAS unsigned char* lds, const Gemm g, const Sched& S, const Epi& E) {
    const int tid = opaque_tid(), wid = __builtin_amdgcn_readfirstlane(tid >> 6), lane = tid & 63, wr = wid >> 2, wc = wid & 3, fr = lane & 15, fq = lane >> 4;
    unsigned voffA[2], voffB[2];
#pragma unroll
    for (int i = 0; i < 2; ++i) { int R, C; stage_rc(tid * 16 + i * 8192, R, C); const int Rb = Epi::PERM ? ((R & ~31) + perm32(R & 31)) : R;
        voffA[i] = (unsigned)(R * g.lda + C) * 2u; voffB[i] = (unsigned)(Rb * g.ldb + C) * 2u; }
    const size_t kstep = (size_t)(BK * 2);
    const size_t hstepA = (size_t)HALF * g.lda * 2, hstepB = (size_t)HALF * g.ldb * 2;
    const size_t tstepA = 2 * hstepA, tstepB = 2 * hstepB;
    const unsigned ldsw = (unsigned)wid * 1024u;
    const int aoff = lds_byte(wr * 64 + fr, fq * 8), boff = lds_byte(wc * 32 + fr, fq * 8);
#define PG8_SA(b, h) (((b) * 2 + (h)) * HTB)
#define PG8_SB(b, h) ((4 + (b) * 2 + (h)) * HTB)
#define PG8_STAGE(bufoff, gbase, voff) do { _Pragma("unroll") for (int _i = 0; _i < 2; ++_i) \
        __builtin_amdgcn_global_load_lds((const unsigned*)((const char*)(gbase) + (voff)[_i]), (LAS unsigned*)(lds + (bufoff) + ldsw + _i * 8192), 16, 0, 0); } while (0)
#define PG8_LDA(dst, b, h) do { _Pragma("unroll") for (int m = 0; m < 4; ++m) _Pragma("unroll") for (int k = 0; k < 2; ++k) dst[m][k] = *(const LAS bf16x8*)(lds + PG8_SA(b, h) + aoff + m * 2048 + k * 1024); } while (0)
#define PG8_LDB(dst, b, h) do { _Pragma("unroll") for (int n = 0; n < 2; ++n) _Pragma("unroll") for (int k = 0; k < 2; ++k) dst[n][k] = *(const LAS bf16x8*)(lds + PG8_SB(b, h) + boff + n * 2048 + k * 1024); } while (0)
#define PG8_MMA(ai, bj, At, Bt) do { __builtin_amdgcn_s_setprio(1); _Pragma("unroll") for (int m = 0; m < 4; ++m) _Pragma("unroll") for (int n = 0; n < 2; ++n) _Pragma("unroll") for (int k = 0; k < 2; ++k) \
        acc[ai][bj][m][n] = __builtin_amdgcn_mfma_f32_16x16x32_bf16(Bt[n][k], At[m][k], acc[ai][bj][m][n], 0, 0, 0); __builtin_amdgcn_s_setprio(0); } while (0)
#define PG8_WAIT_V(n) asm volatile("s_waitcnt vmcnt(" #n ")" ::: "memory")
#define PG8_WAIT_L(n) asm volatile("s_waitcnt lgkmcnt(" #n ")" ::: "memory")
#define PG8_BAR __builtin_amdgcn_s_barrier()
#define PG8_SCHED __builtin_amdgcn_sched_barrier(0)
    Unit cur, nxt; int ui = 0;
    if (!S.next(0, cur)) return;
    f32x4 acc[2][2][4][2];
#pragma unroll
    for (int a = 0; a < 2; ++a)
#pragma unroll
        for (int b = 0; b < 2; ++b)
#pragma unroll
            for (int m = 0; m < 4; ++m)
#pragma unroll
                for (int n = 0; n < 2; ++n) acc[a][b][m][n] = (f32x4){0.f, 0.f, 0.f, 0.f};
    bf16x8 At[4][2], B0[2][2], B1[2][2];
    const char* cA = (const char*)g.A + (size_t)cur.pm * tstepA + (size_t)cur.ak * 2; const char* cB = (const char*)g.Bt + (size_t)cur.pn * tstepB + (size_t)cur.bk * 2;
    PG8_STAGE(PG8_SB(0, 0), cB, voffB); PG8_STAGE(PG8_SB(0, 1), cB + hstepB, voffB); PG8_STAGE(PG8_SA(0, 0), cA, voffA); PG8_STAGE(PG8_SA(0, 1), cA + hstepA, voffA);
    if (wr == 1) PG8_BAR;
    PG8_WAIT_V(2); PG8_BAR;
    PG8_STAGE(PG8_SB(1, 0), cB + kstep, voffB); PG8_STAGE(PG8_SA(1, 0), cA + kstep, voffA); PG8_STAGE(PG8_SB(1, 1), cB + hstepB + kstep, voffB);
    PG8_WAIT_V(6); PG8_BAR;
    for (;;) {
        const bool has_next = S.next(ui + 1, nxt);
        const char* nA = has_next ? (const char*)g.A + (size_t)nxt.pm * tstepA + (size_t)nxt.ak * 2 : cA;
        const char* nB = has_next ? (const char*)g.Bt + (size_t)nxt.pn * tstepB + (size_t)nxt.bk * 2 : cB;
        const int nt = cur.nt;
        for (int t = 0; t < nt; t += 2) {
            const bool last = (t == nt - 2);
            const char* a1 = cA + (size_t)(t + 1) * kstep;
            const char* a2 = last ? nA : cA + (size_t)(t + 2) * kstep; const char* b2 = last ? nB : cB + (size_t)(t + 2) * kstep;
            const char* a3 = a2 + kstep; const char* b3 = b2 + kstep;
            PG8_LDB(B0, 0, 0); PG8_LDB(B1, 0, 1); PG8_SCHED; PG8_LDA(At, 0, 0); PG8_STAGE(PG8_SA(1, 1), a1 + hstepA, voffA);
            PG8_WAIT_V(8); PG8_WAIT_L(0); PG8_BAR; PG8_MMA(0, 0, At, B0); PG8_MMA(0, 1, At, B1); PG8_BAR; PG8_SCHED;
            PG8_LDA(At, 0, 1); PG8_STAGE(PG8_SB(0, 0), b2, voffB); PG8_STAGE(PG8_SB(0, 1), b2 + hstepB, voffB); PG8_STAGE(PG8_SA(0, 0), a2, voffA);
            PG8_WAIT_V(8); PG8_WAIT_L(0); PG8_BAR; PG8_MMA(1, 0, At, B0); PG8_MMA(1, 1, At, B1); PG8_BAR; PG8_SCHED;
            PG8_LDB(B0, 1, 0); PG8_LDB(B1, 1, 1); PG8_SCHED; PG8_LDA(At, 1, 0); PG8_STAGE(PG8_SA(0, 1), a2 + hstepA, voffA);
            PG8_WAIT_V(8); PG8_WAIT_L(0); PG8_BAR; PG8_MMA(0, 0, At, B0); PG8_MMA(0, 1, At, B1); PG8_BAR; PG8_SCHED;
            PG8_LDA(At, 1, 1); PG8_STAGE(PG8_SB(1, 0), b3, voffB); PG8_STAGE(PG8_SB(1, 1), b3 + hstepB, voffB); PG8_STAGE(PG8_SA(1, 0), a3, voffA);
            PG8_WAIT_V(8); PG8_WAIT_L(0); PG8_BAR; PG8_MMA(1, 0, At, B0); PG8_MMA(1, 1, At, B1); PG8_BAR; PG8_SCHED;
        }
        if constexpr (ALIGN_EPI) { if (wr == 0) PG8_BAR; }
        E(acc, cur, wr, wc, fr, fq);
        if (!has_next) break;
#pragma unroll
        for (int a = 0; a < 2; ++a)
#pragma unroll
            for (int b = 0; b < 2; ++b)
#pragma unroll
                for (int m = 0; m < 4; ++m)
#pragma unroll
                    for (int n = 0; n < 2; ++n) acc[a][b][m][n] = (f32x4){0.f, 0.f, 0.f, 0.f};
        cur = nxt; cA = nA; cB = nB; ++ui;
        if constexpr (ALIGN_EPI) { if (wr == 1) PG8_BAR; }
    }
    PG8_WAIT_V(0);
    if constexpr (!ALIGN_EPI) { if (wr == 0) PG8_BAR; }
    PG8_BAR;
#undef PG8_SA
#undef PG8_SB
#undef PG8_STAGE
#undef PG8_LDA
#undef PG8_LDB
#undef PG8_MMA
#undef PG8_WAIT_V
#undef PG8_WAIT_L
#undef PG8_BAR
#undef PG8_SCHED
}
}

struct Params { const float* in[18]; float* out; unsigned char* ws; int ph_lo, ph_hi, coop, pad; };
enum { I_X = 0, I_C, I_G1, I_G2, I_WADA, I_BADA, I_WIN, I_LNG, I_LNB, I_WSP, I_BSP, I_PW, I_PS, I_WBR, I_WOUT, I_WFI, I_WFO, I_FG };

#define MFMA32(a, b, c) __builtin_amdgcn_mfma_f32_32x32x16_bf16(a, b, c, 0, 0, 0)
typedef short v4i16_t __attribute__((ext_vector_type(4)));
__device__ __forceinline__ s16x4 tr_read(LAS const unsigned char* p) { return __builtin_bit_cast(s16x4, __builtin_amdgcn_ds_read_tr16_b64_v4i16((LAS v4i16_t*)p)); }
__device__ __forceinline__ bf16x8 cat8(s16x4 a, s16x4 b) { bf16x8 r; r[0] = a[0]; r[1] = a[1]; r[2] = a[2]; r[3] = a[3]; r[4] = b[0]; r[5] = b[1]; r[6] = b[2]; r[7] = b[3]; return r; }

__device__ __forceinline__ void transpose_tile(LAS float* tl, const float* src, int ld, bf16_t* dst, int ldd) {
    const int tid = opaque_tid();
    { const int r = tid >> 4, c4 = (tid & 15) * 4;
#pragma unroll
      for (int h = 0; h < 2; ++h) { const int k = r + 32 * h; const f32x4 v = *(const f32x4*)(src + (size_t)k * ld + c4);
          tl[k * 65 + c4] = v[0]; tl[k * 65 + c4 + 1] = v[1]; tl[k * 65 + c4 + 2] = v[2]; tl[k * 65 + c4 + 3] = v[3]; } }
    __syncthreads();
    { const int n = tid >> 3, k8 = (tid & 7) * 8; float v[8];
#pragma unroll
      for (int j = 0; j < 8; ++j) v[j] = tl[(k8 + j) * 65 + n];
      u32x4 w; w.x = pk2(v[0], v[1]); w.y = pk2(v[2], v[3]); w.z = pk2(v[4], v[5]); w.w = pk2(v[6], v[7]);
      *(u32x4*)(dst + (size_t)n * ldd + k8) = w; }
    __syncthreads();
}

__device__ __forceinline__ void p0_prologue(const Params& p, LAS unsigned char* lds) {
    const int tid = opaque_tid(), G = gridDim.x, bid = blockIdx.x;
    unsigned char* ws = p.ws;
    bf16_t* WIN = (bf16_t*)(ws + WS_WIN); bf16_t* WMG = (bf16_t*)(ws + WS_WMG); bf16_t* WOUT = (bf16_t*)(ws + WS_WOUT);
    bf16_t* WFI = (bf16_t*)(ws + WS_WFI); bf16_t* WFO = (bf16_t*)(ws + WS_WFO); bf16_t* WPT = (bf16_t*)(ws + WS_WPT); bf16_t* WSP = (bf16_t*)(ws + WS_WSP);
    LAS float* tl = (LAS float*)lds;
    constexpr int TPL = 4304;
    for (int J = bid; J < NL * TPL; J += G) {
        const int l = J / TPL; int j = J - l * TPL;
        const float* src; int ld; bf16_t* dst; int ldd;
        if (j < 768) { const int kt = j / 48, ntile = j % 48;
            src = p.in[I_WIN] + ((size_t)l * DM + kt * 64) * 6144 + ntile * 64; ld = 6144; dst = WIN + ((size_t)l * 3072 + ntile * 64) * DM + kt * 64; ldd = DM; }
        else if (j < 1536) { j -= 768; const int kt = j / 48, ntile = j % 48, br = ntile >> 4, n0 = (ntile & 15) * 64;
            src = p.in[I_WIN] + ((size_t)l * DM + kt * 64) * 6144 + 3072 + ntile * 64; ld = 6144; dst = WMG + ((size_t)l * DM + n0) * WMG_LD + br * 1024 + kt * 64; ldd = WMG_LD; }
        else if (j < 1920) { j -= 1536; const int br = j >> 7, r = j & 127, kt = r >> 4, ntile = r & 15;
            src = p.in[I_WBR] + ((size_t)(l * 3 + br) * BW + kt * 64) * DM + ntile * 64; ld = DM; dst = WMG + ((size_t)l * DM + ntile * 64) * WMG_LD + 3072 + br * 512 + kt * 64; ldd = WMG_LD; }
        else if (j < 2176) { j -= 1920; const int kt = j >> 4, ntile = j & 15;
            src = p.in[I_WOUT] + ((size_t)l * DM + kt * 64) * DM + ntile * 64; ld = DM; dst = WOUT + ((size_t)l * DM + ntile * 64) * DM + kt * 64; ldd = DM; }
        else if (j < 3584) { j -= 2176; const int kt = j / 88, ntile = j % 88, c0 = ntile * 64; const bool up = c0 >= FF; const int f0 = up ? c0 - FF : c0;
            const int np = 256 * (f0 >> 7) + (f0 & 127) + (up ? 128 : 0);
            src = p.in[I_WFI] + ((size_t)l * DM + kt * 64) * (2 * FF) + c0; ld = 2 * FF; dst = WFI + ((size_t)l * (2 * FF) + np) * DM + kt * 64; ldd = DM; }
        else if (j < 4288) { j -= 3584; const int kt = j >> 4, ntile = j & 15;
            src = p.in[I_WFO] + ((size_t)l * FF + kt * 64) * DM + ntile * 64; ld = DM; dst = WFO + ((size_t)l * DM + ntile * 64) * FF + kt * 64; ldd = FF; }
        else { j -= 4288; const int gg = j >> 2, r = j & 3, kt = r >> 1, ntile = r & 1;
            src = p.in[I_PW] + ((size_t)(l * 4 + gg) * 128 + kt * 64) * 128 + ntile * 64; ld = 128; dst = WPT + ((size_t)(l * 4 + gg) * 128 + ntile * 64) * 128 + kt * 64; ldd = 128; }
        transpose_tile(tl, src, ld, dst, ldd);
    }
    for (int idx = bid * 512 + tid; idx < NL * 4 * 128 * 128; idx += G * 512) { const int t = (idx >> 7) & 127, s = idx & 127; WSP[idx] = (s <= t) ? (bf16_t)f2bf(p.in[I_WSP][idx]) : (bf16_t)0; }
    LAS float* ca = (LAS float*)lds;
    float* MOD = (float*)(ws + WS_MOD);
    for (int cgp = bid; cgp < (NL * NMOD) / 96; cgp += G) {
        __syncthreads();
        for (int i = tid; i < NB * DM; i += 512) { const int b = i >> 10, k = i & 1023; const float cv = p.in[I_C][i]; ca[k * 32 + b] = cv * fast_sigmoid(cv); }
        __syncthreads();
        const int cj = tid & 31, ks = tid >> 5;
        float acc[3][32];
#pragma unroll
        for (int q = 0; q < 3; ++q)
#pragma unroll
            for (int b = 0; b < 32; ++b) acc[q][b] = 0.f;
        const int colg = cgp * 96;
        const int l = colg / NMOD, cl = colg - l * NMOD;
        const float* wa = p.in[I_WADA] + (size_t)l * DM * NMOD + cl + cj;
        for (int k = ks * 64; k < ks * 64 + 64; ++k) {
            float w[3];
#pragma unroll
            for (int q = 0; q < 3; ++q) w[q] = wa[(size_t)k * NMOD + q * 32];
            f32x4 cv[8];
#pragma unroll
            for (int i = 0; i < 8; ++i) cv[i] = *(const LAS f32x4*)(ca + k * 32 + i * 4);
#pragma unroll
            for (int q = 0; q < 3; ++q)
#pragma unroll
                for (int b = 0; b < 32; ++b) acc[q][b] += cv[b >> 2][b & 3] * w[q];
        }
        LAS float* red = (LAS float*)lds;
#pragma unroll
        for (int q = 0; q < 3; ++q) {
            __syncthreads();
#pragma unroll
            for (int b = 0; b < 32; ++b) red[(ks * 32 + b) * 32 + cj] = acc[q][b];
            __syncthreads();
            for (int o = tid; o < 1024; o += 512) { const int b = o >> 5, c = o & 31; float s = 0.f;
#pragma unroll
                for (int k2 = 0; k2 < 16; ++k2) s += red[(k2 * 32 + b) * 32 + c];
                const int col = cl + q * 32 + c;
                MOD[((size_t)l * NB + b) * NMOD + col] = s + p.in[I_BADA][(size_t)l * NMOD + col]; }
        }
    }
    __syncthreads();
}

__device__ __forceinline__ void norm_phase(const pg8::XInfo& X, const float* xs, const float* g, const float* modl, int shoff, int scoff, bf16_t* act) {
    const int tid_ = opaque_tid(), lane = tid_ & 63, wid = tid_ >> 6;
    for (int blk = X.r * 8 + wid; blk < X.nbx * 64; blk += X.cnt * 8) {
        const int b = X.xi + (blk >> 6) * X.nx, row0 = b * SEQ + (blk & 63) * 32;
        f32x4 ga[4], sh[4];
#pragma unroll
        for (int j = 0; j < 4; ++j) { const int col = j * 256 + lane * 4; const f32x4 gv = *(const f32x4*)(g + col), sc = *(const f32x4*)(modl + (size_t)b * NMOD + scoff + col);
            ga[j] = gv * (1.0f + sc); sh[j] = *(const f32x4*)(modl + (size_t)b * NMOD + shoff + col); }
#pragma unroll 2
        for (int r = 0; r < 32; ++r) {
            const float* xr = xs + (size_t)(row0 + r) * DM + lane * 4;
            f32x4 x[4]; float ss = 0.f;
#pragma unroll
            for (int j = 0; j < 4; ++j) { x[j] = *(const f32x4*)(xr + j * 256); ss += x[j][0] * x[j][0] + x[j][1] * x[j][1] + x[j][2] * x[j][2] + x[j][3] * x[j][3]; }
            ss = wave_sum(ss, lane);
            const float rstd = 1.0f / sqrtf(ss * (1.0f / DM) + EPS);
            bf16_t* orow = act + (size_t)(row0 + r) * ACT_LD + lane * 4;
#pragma unroll
            for (int j = 0; j < 4; ++j) { const f32x4 y = x[j] * rstd * ga[j] + sh[j]; u32x2 w; w.x = pk2(y[0], y[1]); w.y = pk2(y[2], y[3]); *(u32x2*)(orow + j * 256) = w; }
        }
    }
}
__device__ __forceinline__ void final_norm(const pg8::XInfo& X, float* x, const float* g) {
    const int tid_ = opaque_tid(), lane = tid_ & 63, wid = tid_ >> 6;
    f32x4 gv[4];
#pragma unroll
    for (int j = 0; j < 4; ++j) gv[j] = *(const f32x4*)(g + j * 256 + lane * 4);
    for (int rl = X.r * 8 + wid; rl < X.nbx * SEQ; rl += X.cnt * 8) {
        const int row = (X.xi + (rl >> 11) * X.nx) * SEQ + (rl & 2047);
        float* xr = x + (size_t)row * DM + lane * 4;
        f32x4 v[4]; float ss = 0.f;
#pragma unroll
        for (int j = 0; j < 4; ++j) { v[j] = *(const f32x4*)(xr + j * 256); ss += v[j][0] * v[j][0] + v[j][1] * v[j][1] + v[j][2] * v[j][2] + v[j][3] * v[j][3]; }
        ss = wave_sum(ss, lane);
        const float rstd = 1.0f / sqrtf(ss * (1.0f / DM) + EPS);
#pragma unroll
        for (int j = 0; j < 4; ++j) *(f32x4*)(xr + j * 256) = v[j] * rstd * gv[j];
    }
}

__device__ __forceinline__ void gmlp_unit(LAS unsigned char* lds, int b, int ch, const bf16_t* mid, const bf16_t* wsp, const float* lng, const float* lnb, const float* bsp, bf16_t* act) {
    const int tid = opaque_tid(), lane = tid & 63, wid = tid >> 6;
    const int row0 = b * SEQ + ch * 128;
    {
        const int s = tid >> 2, q = tid & 3;
        const bf16_t* vp = mid + (size_t)(row0 + s) * MID_LD + 512 + q * 8;
        float sum = 0.f, sq = 0.f;
#pragma unroll 4
        for (int i = 0; i < 16; ++i) { const u32x4 v = *(const u32x4*)(vp + i * 32);
            const float a0 = bflo(v.x), a1 = bfhi(v.x), a2 = bflo(v.y), a3 = bfhi(v.y), a4 = bflo(v.z), a5 = bfhi(v.z), a6 = bflo(v.w), a7 = bfhi(v.w);
            sum += ((a0 + a1) + (a2 + a3)) + ((a4 + a5) + (a6 + a7));
            sq += ((a0 * a0 + a1 * a1) + (a2 * a2 + a3 * a3)) + ((a4 * a4 + a5 * a5) + (a6 * a6 + a7 * a7)); }
        sum += shx(sum, lane, 1); sum += shx(sum, lane, 2);
        sq += shx(sq, lane, 1); sq += shx(sq, lane, 2);
        const float mean = sum * (1.0f / BW);
        const float var = fmaxf(sq * (1.0f / BW) - mean * mean, 0.f);
        const float rstd = 1.0f / sqrtf(var + EPS);
#pragma unroll 2
        for (int i = 0; i < 16; ++i) {
            const int c = (4 * i + q) * 8;
            const u32x4 v = *(const u32x4*)(vp + i * 32);
            const f32x4 g0 = *(const f32x4*)(lng + c), g1 = *(const f32x4*)(lng + c + 4), b0 = *(const f32x4*)(lnb + c), b1 = *(const f32x4*)(lnb + c + 4);
            u32x4 w;
            w.x = pk2((bflo(v.x) - mean) * rstd * g0[0] + b0[0], (bfhi(v.x) - mean) * rstd * g0[1] + b0[1]);
            w.y = pk2((bflo(v.y) - mean) * rstd * g0[2] + b0[2], (bfhi(v.y) - mean) * rstd * g0[3] + b0[3]);
            w.z = pk2((bflo(v.z) - mean) * rstd * g1[0] + b1[0], (bfhi(v.z) - mean) * rstd * g1[1] + b1[1]);
            w.w = pk2((bflo(v.w) - mean) * rstd * g1[2] + b1[2], (bfhi(v.w) - mean) * rstd * g1[3] + b1[3]);
            *(LAS u32x4*)(lds + i * 8192 + s * 64 + q * 16) = w;
        }
    }
    __syncthreads();
    {
        const int g = wid >> 1, hh = lane >> 5, l32 = lane & 31, i16 = lane & 15, g16 = lane >> 4;
        const unsigned troff = (unsigned)((4 * hh + (i16 >> 2)) * 64 + (16 * (g16 & 1) + 4 * (i16 & 3)) * 2);
#pragma unroll 1
        for (int nti = 0; nti < 2; ++nti) {
            const int nt = (wid & 1) ? (1 + nti) : (nti * 3);
            f32x16 acc[4];
#pragma unroll
            for (int mt = 0; mt < 4; ++mt)
#pragma unroll
                for (int e = 0; e < 16; ++e) acc[mt][e] = 0.f;
            const bf16_t* wrow = wsp + (size_t)(g * 128 + nt * 32 + l32) * 128 + 4 * hh;
            const int nkk = 2 * nt + 2;
            bf16x8 bfr[8];
#pragma unroll
            for (int kk = 0; kk < 8; ++kk) {
                u32x4 bw = {0u, 0u, 0u, 0u};
                if (kk < nkk) { const u32x2 lo = *(const u32x2*)(wrow + kk * 16), hi = *(const u32x2*)(wrow + kk * 16 + 8); bw.x = lo.x; bw.y = lo.y; bw.z = hi.x; bw.w = hi.y; }
                bfr[kk] = __builtin_bit_cast(bf16x8, bw);
            }
#pragma unroll
            for (int kk = 0; kk < 8; ++kk) {
                if (kk < nkk) {
#pragma unroll
                    for (int mt = 0; mt < 4; ++mt) {
                        LAS const unsigned char* ap = lds + (4 * g + mt) * 8192 + kk * 1024 + troff;
                        const bf16x8 afrag = cat8(tr_read(ap), tr_read(ap + 512));
                        acc[mt] = MFMA32(afrag, bfr[kk], acc[mt]);
                    }
                }
            }
            const int t = nt * 32 + l32; const size_t row = (size_t)(row0 + t);
            const float bs = bsp[g * 128 + t];
#pragma unroll
            for (int mt = 0; mt < 4; ++mt)
#pragma unroll
                for (int a = 0; a < 4; ++a) {
                    const int c0 = g * 128 + mt * 32 + a * 8 + 4 * hh;
                    const u32x2 uu = *(const u32x2*)(mid + row * MID_LD + c0);
                    u32x2 w;
                    w.x = pk2(bflo(uu.x) * (acc[mt][4 * a + 0] + bs), bfhi(uu.x) * (acc[mt][4 * a + 1] + bs));
                    w.y = pk2(bflo(uu.y) * (acc[mt][4 * a + 2] + bs), bfhi(uu.y) * (acc[mt][4 * a + 3] + bs));
                    *(u32x2*)(act + row * ACT_LD + 1024 + c0) = w;
                }
        }
    }
    __syncthreads();
}

__device__ __forceinline__ void pool_unit(LAS unsigned char* lds, int b, int tl, const bf16_t* mid, const bf16_t* wpt, const float* pscale, bf16_t* act) {
    const int tid = opaque_tid(), lane = tid & 63, wid = tid >> 6;
    const int row0 = b * SEQ + tl * 128, pos0 = tl * 128;
    const int hh = lane >> 5, l32 = lane & 31;
    LAS unsigned char* xa = lds;
    LAS unsigned char* dt = lds + 40960;
#pragma unroll 1
    for (int g = 0; g < 4; ++g) {
        const int w = 2 << g;
        for (int item = tid; item < 144 * 16; item += 512) {
            const int r = item >> 4, chn = item & 15, pos = pos0 - 16 + r;
            u32x4 v = {0u, 0u, 0u, 0u};
            if (pos >= 0) v = *(const u32x4*)(mid + (size_t)(row0 - 16 + r) * MID_LD + 2560 + g * 128 + chn * 8);
            *(LAS u32x4*)(xa + r * 272 + chn * 16) = v;
        }
        __syncthreads();
#pragma unroll 1
        for (int it = 0; it < 4; ++it) {
            const int item = tid + it * 512, t = item >> 4, chn = item & 15;
            const int pos = pos0 + t, cnt = (pos + 1 < w) ? pos + 1 : w;
            LAS const unsigned char* xp = xa + (t + 16) * 272 + chn * 16;
            const u32x4 x0 = *(const LAS u32x4*)xp;
            float a[8] = {0.f, 0.f, 0.f, 0.f, 0.f, 0.f, 0.f, 0.f};
#pragma unroll 2
            for (int j = 0; j < w; ++j) { const u32x4 xv = *(const LAS u32x4*)(xp - j * 272);
                a[0] += bflo(xv.x); a[1] += bfhi(xv.x); a[2] += bflo(xv.y); a[3] += bfhi(xv.y); a[4] += bflo(xv.z); a[5] += bfhi(xv.z); a[6] += bflo(xv.w); a[7] += bfhi(xv.w); }
            const float inv = 1.0f / (float)cnt;
            u32x4 o; o.x = pk2(a[0] * inv - bflo(x0.x), a[1] * inv - bfhi(x0.x)); o.y = pk2(a[2] * inv - bflo(x0.y), a[3] * inv - bfhi(x0.y));
            o.z = pk2(a[4] * inv - bflo(x0.z), a[5] * inv - bfhi(x0.z)); o.w = pk2(a[6] * inv - bflo(x0.w), a[7] * inv - bfhi(x0.w));
            *(LAS u32x4*)(dt + t * 272 + chn * 16) = o;
        }
        __syncthreads();
        {
            const int mt = wid & 3, nt0 = (wid >> 2) * 2;
            bf16x8 af[8];
            const bf16_t* ap = wpt + (size_t)(g * 128 + mt * 32 + l32) * 128 + 8 * hh;
#pragma unroll
            for (int kk = 0; kk < 8; ++kk) af[kk] = *(const bf16x8*)(ap + kk * 16);
#pragma unroll 1
            for (int nti = 0; nti < 2; ++nti) {
                const int nt = nt0 + nti;
                f32x16 acc;
#pragma unroll
                for (int e = 0; e < 16; ++e) acc[e] = 0.f;
                LAS const unsigned char* bp = dt + (nt * 32 + l32) * 272 + 16 * hh;
#pragma unroll
                for (int kk = 0; kk < 8; ++kk) { const bf16x8 bf = *(const LAS bf16x8*)(bp + kk * 32); acc = MFMA32(af[kk], bf, acc); }
                const size_t row = (size_t)(row0 + nt * 32 + l32);
#pragma unroll
                for (int a = 0; a < 4; ++a) { const int dd = g * 128 + mt * 32 + a * 8 + 4 * hh; const f32x4 sc = *(const f32x4*)(pscale + dd);
                    u32x2 o; o.x = pk2(acc[4 * a] * sc[0], acc[4 * a + 1] * sc[1]); o.y = pk2(acc[4 * a + 2] * sc[2], acc[4 * a + 3] * sc[3]);
                    *(u32x2*)(act + row * ACT_LD + 2048 + dd) = o; }
            }
        }
        __syncthreads();
    }
}

constexpr int ATT_SLOT = 8704, ATT_WIN = 13, ATT_BACK = 5, ATT_PRIV = ATT_WIN * ATT_SLOT;
static_assert(ATT_PRIV + 8 * 4096 <= LDS_BYTES, "attention LDS map");
__device__ __forceinline__ void attn_wg(LAS unsigned char* lds, int b, int h, int qb0, const bf16_t* mid, bf16_t* act, int tid) {
    const int lane = tid & 63, wid = __builtin_amdgcn_readfirstlane(tid >> 6);
    const int hh = lane >> 5, ql = lane & 31, i16 = lane & 15, g16 = lane >> 4;
    const int qb = qb0 + wid;
    const int win_lo = qb0 > ATT_BACK ? qb0 - ATT_BACK : 0, nwin = qb0 + 8 - win_lo;
    const size_t rowq = (size_t)b * SEQ + qb * 32 + ql;
    bf16x8 qf[4];
#pragma unroll
    for (int kk = 0; kk < 4; ++kk) qf[kk] = *(const bf16x8*)(mid + rowq * MID_LD + 1024 + h * 64 + kk * 16 + 8 * hh);
    {
        const int isv = tid >> 8, t8 = tid & 255, row = t8 >> 3, ch = t8 & 7;
        const bf16_t* src = mid + ((size_t)b * SEQ + row) * MID_LD + (isv ? 2048 : 1536) + h * 64 + ch * 8;
        const unsigned dsto = isv ? (unsigned)(4608 + (ch >> 2) * 2048 + row * 64 + (ch & 3) * 16) : (unsigned)(row * 144 + ch * 16);
        u32x4 v[ATT_WIN];
#pragma unroll
        for (int i = 0; i < ATT_WIN; ++i) if (i < nwin) v[i] = *(const u32x4*)(src + (size_t)(win_lo + i) * 32 * MID_LD);
#pragma unroll
        for (int i = 0; i < ATT_WIN; ++i) if (i < nwin) *(LAS u32x4*)(lds + i * ATT_SLOT + dsto) = v[i];
    }
    __syncthreads();
    f32x16 o0, o1;
#pragma unroll
    for (int e = 0; e < 16; ++e) { o0[e] = 0.f; o1[e] = 0.f; }
    float C = 1.0f;
    const unsigned troff = (unsigned)((4 * hh + (i16 >> 2)) * 64 + (16 * (g16 & 1) + 4 * (i16 & 3)) * 2);
    LAS unsigned char* vl = lds + ATT_PRIV + wid * 4096;
    const bf16_t* kbase = mid + ((size_t)b * SEQ + ql) * MID_LD + 1536 + h * 64 + 8 * hh;
    const bf16_t* vbase = mid + ((size_t)b * SEQ + ql) * MID_LD + 2048 + h * 64 + 8 * hh;
#pragma unroll 1
    for (int kt = qb; kt >= 0; --kt) {
        f32x16 s;
#pragma unroll
        for (int e = 0; e < 16; ++e) s[e] = 0.f;
        LAS const unsigned char* vimg;
        if (kt >= win_lo) {
            LAS const unsigned char* sl = lds + (kt - win_lo) * ATT_SLOT;
#pragma unroll
            for (int kk = 0; kk < 4; ++kk) { const bf16x8 kf = *(const LAS bf16x8*)(sl + ql * 144 + kk * 32 + hh * 16); s = MFMA32(kf, qf[kk], s); }
            vimg = sl + 4608;
        } else {
            bf16x8 kf[4]; u32x4 vv[4];
#pragma unroll
            for (int c = 0; c < 4; ++c) { kf[c] = *(const bf16x8*)(kbase + (size_t)kt * 32 * MID_LD + c * 16); vv[c] = *(const u32x4*)(vbase + (size_t)kt * 32 * MID_LD + c * 16); }
#pragma unroll
            for (int c = 0; c < 4; ++c) { const int chn = hh + 2 * c; *(LAS u32x4*)(vl + (chn >> 2) * 2048 + ql * 64 + (chn & 3) * 16) = vv[c]; }
#pragma unroll
            for (int kk = 0; kk < 4; ++kk) s = MFMA32(kf[kk], qf[kk], s);
            vimg = vl;
        }
        float bt[16], om[16];
        const bool diag = (kt == qb);
#pragma unroll
        for (int r = 0; r < 16; ++r) {
            const float e = __builtin_amdgcn_exp2f(fminf(s[r] * LOG2E, 100.0f));
            float o1_ = __builtin_amdgcn_rcpf(1.0f + e), b1 = e * o1_;
            const int keyl = 8 * (r >> 2) + 4 * hh + (r & 3);
            if (diag && keyl >= ql) { o1_ = 1.0f; b1 = 0.0f; }
            om[r] = o1_; bt[r] = b1;
        }
        float g4[4], pg[4];
#pragma unroll
        for (int a = 0; a < 4; ++a) g4[a] = (om[4 * a] * om[4 * a + 1]) * (om[4 * a + 2] * om[4 * a + 3]);
#pragma unroll
        for (int a = 0; a < 4; ++a) pg[a] = shx(g4[a], lane, 32);
        float after = 1.0f; float pa[16];
#pragma unroll
        for (int a = 3; a >= 0; --a) {
            const float s3 = C * after * (hh == 0 ? pg[a] : 1.0f), s2 = s3 * om[4 * a + 3], s1 = s2 * om[4 * a + 2], s0 = s1 * om[4 * a + 1];
            pa[4 * a + 3] = bt[4 * a + 3] * s3; pa[4 * a + 2] = bt[4 * a + 2] * s2; pa[4 * a + 1] = bt[4 * a + 1] * s1; pa[4 * a + 0] = bt[4 * a + 0] * s0;
            after *= g4[a] * pg[a];
        }
        C *= after;
#pragma unroll
        for (int kk2 = 0; kk2 < 2; ++kk2) {
            u32x4 pw; pw.x = pk2(pa[8 * kk2 + 0], pa[8 * kk2 + 1]); pw.y = pk2(pa[8 * kk2 + 2], pa[8 * kk2 + 3]); pw.z = pk2(pa[8 * kk2 + 4], pa[8 * kk2 + 5]); pw.w = pk2(pa[8 * kk2 + 6], pa[8 * kk2 + 7]);
            const bf16x8 pf = __builtin_bit_cast(bf16x8, pw);
            LAS const unsigned char* ap = vimg + kk2 * 1024 + troff;
            const bf16x8 a0 = cat8(tr_read(ap), tr_read(ap + 512));
            const bf16x8 a1 = cat8(tr_read(ap + 2048), tr_read(ap + 2048 + 512));
            o0 = MFMA32(a0, pf, o0); o1 = MFMA32(a1, pf, o1);
        }
        if (__all(C < 1.0e-38f)) break;
    }
    bf16_t* op = act + rowq * ACT_LD + 1536 + h * 64 + 4 * hh;
#pragma unroll
    for (int a = 0; a < 4; ++a) {
        u32x2 w0, w1; w0.x = pk2(o0[4 * a], o0[4 * a + 1]); w0.y = pk2(o0[4 * a + 2], o0[4 * a + 3]); w1.x = pk2(o1[4 * a], o1[4 * a + 1]); w1.y = pk2(o1[4 * a + 2], o1[4 * a + 3]);
        *(u32x2*)(op + a * 8) = w0; *(u32x2*)(op + 32 + a * 8) = w1;
    }
    __syncthreads();
}

__global__ void __launch_bounds__(512, 2) fwd_megakernel(Params p) {
    extern __shared__ __attribute__((aligned(16))) unsigned char lds_raw[];
    LAS unsigned char* lds = (LAS unsigned char*)lds_raw;
    cg::grid_group grid = cg::this_grid();
    unsigned* const gbar = (unsigned*)p.ws; unsigned gtarget = 0;
#define GSYNC() do { asm volatile("s_waitcnt vmcnt(0) lgkmcnt(0)" ::: "memory"); __syncthreads(); gtarget = (unsigned)__builtin_amdgcn_readfirstlane((int)(gtarget + gridDim.x)); \
        if (threadIdx.x == 0) { __builtin_amdgcn_fence(__ATOMIC_RELEASE, "agent"); asm volatile("s_waitcnt vmcnt(0)" ::: "memory"); \
            __hip_atomic_fetch_add(gbar, 1u, __ATOMIC_RELAXED, __HIP_MEMORY_SCOPE_AGENT); \
            while (__hip_atomic_load(gbar, __ATOMIC_RELAXED, __HIP_MEMORY_SCOPE_AGENT) < gtarget) __builtin_amdgcn_s_sleep(2); } \
        __syncthreads(); __builtin_amdgcn_fence(__ATOMIC_ACQUIRE, "agent"); asm volatile("s_waitcnt vmcnt(0)" ::: "memory"); } while (0)
    unsigned xtarget = 0;
#define XSYNC() do { asm volatile("s_waitcnt vmcnt(0) lgkmcnt(0)" ::: "memory"); __syncthreads(); xtarget = (unsigned)__builtin_amdgcn_readfirstlane((int)(xtarget + (unsigned)X.cnt)); \
        if (threadIdx.x == 0) { __hip_atomic_fetch_add(xbar, 1u, __ATOMIC_RELAXED, __HIP_MEMORY_SCOPE_AGENT); \
            while (__hip_atomic_load(xbar, __ATOMIC_RELAXED, __HIP_MEMORY_SCOPE_AGENT) < xtarget) __builtin_amdgcn_s_sleep(1); } \
        __syncthreads(); __builtin_amdgcn_fence(__ATOMIC_ACQUIRE, "agent"); asm volatile("s_waitcnt vmcnt(0)" ::: "memory"); } while (0)
    grid.sync();
    const int G = gridDim.x, bid = blockIdx.x, tid = threadIdx.x;
    typedef const Params __attribute__((address_space(4)))* KArg;
    KArg kp = (KArg)__builtin_amdgcn_kernarg_segment_ptr();

    pg8::XInfo X;
    { LAS unsigned* sh = (LAS unsigned*)(lds + 131072);
      if (tid == 0) { const unsigned xc = (unsigned)__builtin_amdgcn_s_getreg((3 << 11) | 20) & 0xFu;
          sh[0] = xc; sh[1] = __hip_atomic_fetch_add(gbar + 64 + 64 * xc, 1u, __ATOMIC_RELAXED, __HIP_MEMORY_SCOPE_AGENT); }
      __syncthreads();
      const unsigned xcc = sh[0]; X.r = (int)sh[1];
      p0_prologue(p, lds);
      GSYNC();
      int nx = 0, xi = 0, cnt = 0;
      for (unsigned j = 0; j < 16; ++j) { const unsigned cj = __hip_atomic_load(gbar + 64 + 64 * j, __ATOMIC_RELAXED, __HIP_MEMORY_SCOPE_AGENT); if (cj) { if (j == xcc) { xi = nx; cnt = (int)cj; } ++nx; } }
      X.xi = __builtin_amdgcn_readfirstlane(xi); X.nx = __builtin_amdgcn_readfirstlane(nx); X.cnt = __builtin_amdgcn_readfirstlane(cnt); X.r = __builtin_amdgcn_readfirstlane(X.r);
      X.nbx = (NB - X.xi + X.nx - 1) / X.nx; }
    unsigned* const xbar = gbar + 2048 + 64 * __builtin_amdgcn_readfirstlane((int)((LAS unsigned*)(lds + 131072))[0]);
#pragma unroll 1
    for (int l = 0; l < NL; ++l) {
        KArg q = kp; asm volatile("" : "+s"(q));
        unsigned char* ws = q->ws; float* xout = q->out;
        float* MOD = (float*)(ws + WS_MOD);
        bf16_t* WSP = (bf16_t*)(ws + WS_WSP); bf16_t* WPT = (bf16_t*)(ws + WS_WPT);
        bf16_t* WIN = (bf16_t*)(ws + WS_WIN); bf16_t* WMG = (bf16_t*)(ws + WS_WMG); bf16_t* WOUT = (bf16_t*)(ws + WS_WOUT);
        bf16_t* WFI = (bf16_t*)(ws + WS_WFI); bf16_t* WFO = (bf16_t*)(ws + WS_WFO);
        bf16_t* ACT = (bf16_t*)(ws + WS_ACT); bf16_t* MID = (bf16_t*)(ws + WS_MID); bf16_t* MRG = (bf16_t*)(ws + WS_MRG); bf16_t* FB = (bf16_t*)(ws + WS_F);
        const float* xs = (l == 0) ? q->in[I_X] : xout;
        const float* modl = MOD + (size_t)l * NB * NMOD;
        norm_phase(X, xs, q->in[I_G1] + l * DM, modl, 0, DM, ACT);
        XSYNC();
        { pg8::Gemm g{ACT, WIN + (size_t)l * 3072 * DM, ACT_LD, DM}; pg8::StaticOrder S; S.init(X, 3072, 16); pg8::EpiIn E{MID};
          pg8::gemm_phase<pg8::EpiIn, pg8::StaticOrder>(lds, g, S, E); }
        XSYNC();
        for (int u = X.r; u < X.nbx * 16; u += X.cnt)
            gmlp_unit(lds, X.xi + (u >> 4) * X.nx, u & 15, MID, WSP + (size_t)l * 4 * 128 * 128, q->in[I_LNG] + l * BW, q->in[I_LNB] + l * BW, q->in[I_BSP] + l * 4 * 128, ACT);
        for (int u = X.r; u < X.nbx * 16; u += X.cnt)
            pool_unit(lds, X.xi + (u >> 4) * X.nx, u & 15, MID, WPT + (size_t)l * 4 * 128 * 128, q->in[I_PS] + l * BW, ACT);
        { const int t2 = opaque_tid();
          for (int wu = X.r; wu < X.nbx * 64; wu += X.cnt) { const int bhl = wu >> 3;
              attn_wg(lds, X.xi + (bhl >> 3) * X.nx, bhl & 7, (wu & 7) * 8, MID, ACT, t2); } }
        XSYNC();
        { const int sb = X.xi + (X.r >> 5) * X.nx;
          unsigned char* scr = ws + WS_SCR + (size_t)sb * SEQ * MID_LD * 2 + (size_t)(X.r & 31) * SCR_PER_WG;
          pg8::Gemm g{ACT, WMG + (size_t)l * DM * WMG_LD, ACT_LD, WMG_LD}; pg8::MergeOrder S; S.init(X);
          pg8::EpiMerge E{(u32x4*)scr, (f32x4*)(scr + 131072), MRG};
          pg8::gemm_phase<pg8::EpiMerge, pg8::MergeOrder>(lds, g, S, E); }
        XSYNC();
        { pg8::Gemm g{MRG, WOUT + (size_t)l * DM * DM, DM, DM}; pg8::StaticOrder S; S.init(X, DM, 16); pg8::EpiRes E{xs, xout, modl + 2 * DM};
          pg8::gemm_phase<pg8::EpiRes, pg8::StaticOrder>(lds, g, S, E); }
        XSYNC();
        norm_phase(X, xout, q->in[I_G2] + l * DM, modl, 3 * DM, 4 * DM, ACT);
        XSYNC();
        { pg8::Gemm g{ACT, WFI + (size_t)l * 2 * FF * DM, ACT_LD, DM}; pg8::StaticOrder S; S.init(X, 2 * FF, 16); pg8::EpiFfn E{FB};
          pg8::gemm_phase<pg8::EpiFfn, pg8::StaticOrder>(lds, g, S, E); }
        XSYNC();
        { pg8::Gemm g{FB, WFO + (size_t)l * DM * FF, MID_LD, FF}; pg8::StaticOrder S; S.init(X, DM, FF / 64); pg8::EpiRes E{xout, xout, modl + 5 * DM};
          pg8::gemm_phase<pg8::EpiRes, pg8::StaticOrder>(lds, g, S, E); }
        XSYNC();
    }
    final_norm(X, kp->out, kp->in[I_FG]);
}

extern "C" void kernel_launch(void* const* d_in, const int* in_sizes, int n_in, void* d_out, int out_size, void* d_ws, size_t ws_size, hipStream_t stream) {
    static int grid = 0;
    if (grid == 0) {
        if (n_in != 18 || in_sizes[0] != NTOK * DM || out_size != NTOK * DM || ws_size < WS_END) {
            fprintf(stderr, "kernel_launch: unexpected shapes (n_in %d, in0 %d, out %d, ws %zu, need %zu)\n", n_in, n_in > 0 ? in_sizes[0] : -1, out_size, ws_size, (size_t)WS_END); grid = -1; return; }
        int dev = 0, cus = 0, per_cu = 0;
        if (hipGetDevice(&dev) != hipSuccess || hipDeviceGetAttribute(&cus, hipDeviceAttributeMultiprocessorCount, dev) != hipSuccess) { grid = -1; return; }
        if (hipFuncSetAttribute((const void*)fwd_megakernel, hipFuncAttributeMaxDynamicSharedMemorySize, LDS_BYTES) != hipSuccess) { fprintf(stderr, "kernel_launch: hipFuncSetAttribute failed\n"); grid = -1; return; }
        if (hipOccupancyMaxActiveBlocksPerMultiprocessor(&per_cu, (const void*)fwd_megakernel, 512, LDS_BYTES) != hipSuccess || per_cu < 1) { fprintf(stderr, "kernel_launch: occupancy query gave %d\n", per_cu); per_cu = 1; }
        (void)hipGetLastError();
        grid = cus < MAX_GRID ? cus : MAX_GRID;
    }
    if (grid < 0) return;
    if (hipMemsetAsync(d_ws, 0, 16384, stream) != hipSuccess) { fprintf(stderr, "kernel_launch: memset failed\n"); return; }
    Params p{};
    for (int i = 0; i < 18; ++i) p.in[i] = (const float*)d_in[i];
    p.out = (float*)d_out; p.ws = (unsigned char*)d_ws;
    p.ph_lo = 0; p.ph_hi = 46; p.coop = 1;
    void* args[] = {&p};
    hipError_t e = hipLaunchCooperativeKernel((const void*)fwd_megakernel, dim3(grid), dim3(512), args, LDS_BYTES, stream);
    if (e != hipSuccess) fprintf(stderr, "cooperative launch failed: %s (grid %d)\n", hipGetErrorString(e), grid);
}
```

```cpp
#include <hip/hip_runtime.h>
#include <hip/hip_cooperative_groups.h>
#include <cstdio>
#include <cstdint>
namespace cg = cooperative_groups;

#define LAS __attribute__((address_space(3)))
typedef unsigned short bf16_t;
typedef short bf16x8 __attribute__((ext_vector_type(8)));
typedef short s16x4 __attribute__((ext_vector_type(4)));
typedef float f32x4 __attribute__((ext_vector_type(4)));
typedef float f32x2 __attribute__((ext_vector_type(2)));
typedef float f32x16 __attribute__((ext_vector_type(16)));
typedef unsigned u32x4 __attribute__((ext_vector_type(4)));
typedef unsigned u32x2 __attribute__((ext_vector_type(2)));

constexpr int NB = 32, SEQ = 2048, DM = 1024, NTOK = NB * SEQ, NL = 4, BW = 512, FF = 2816;
constexpr int ACT_LD = 2560;
constexpr int MID_LD = 3072;
constexpr int WMG_LD = 4608;
constexpr int NMOD = 6 * DM;
constexpr float EPS = 1e-6f;
constexpr float LOG2E = 1.4426950408889634f;

constexpr size_t MiB = (size_t)1 << 20;
constexpr size_t WS_MOD = 1 * MiB;
constexpr size_t WS_WSP = 4 * MiB;
constexpr size_t WS_WPT = 5 * MiB;
constexpr size_t WS_WIN = 6 * MiB;
constexpr size_t WS_WMG = 30 * MiB;
constexpr size_t WS_WOUT = 66 * MiB;
constexpr size_t WS_WFI = 74 * MiB;
constexpr size_t WS_WFO = 118 * MiB;
constexpr size_t WS_ACT = 140 * MiB;
constexpr size_t WS_MID = 460 * MiB;
constexpr size_t WS_SCR = 460 * MiB;
constexpr size_t SCR_PER_WG = 384 * 1024;
static_assert((size_t)SEQ * MID_LD * 2 == 32 * SCR_PER_WG, "a batch's MID block holds exactly 32 scratch slots");
constexpr size_t WS_MRG = 844 * MiB;
constexpr size_t WS_F = 460 * MiB;
constexpr size_t WS_END = 972 * MiB;
constexpr int MAX_GRID = 256;

constexpr int LDS_BYTES = 147456;

__device__ __forceinline__ unsigned f2bf(float f) { unsigned u = __builtin_bit_cast(unsigned, f); return (u + 0x7fffu + ((u >> 16) & 1u)) >> 16; }
typedef __bf16 bf16x2_t __attribute__((ext_vector_type(2)));
__device__ __forceinline__ unsigned pk2(float lo, float hi) { const f32x2 v = {lo, hi}; return __builtin_bit_cast(unsigned, __builtin_convertvector(v, bf16x2_t)); }
__device__ __forceinline__ float bflo(unsigned u) { return __builtin_bit_cast(float, u << 16); }
__device__ __forceinline__ float bfhi(unsigned u) { return __builtin_bit_cast(float, u & 0xffff0000u); }
__device__ __forceinline__ float fast_sigmoid(float x) { return __builtin_amdgcn_rcpf(1.0f + __builtin_amdgcn_exp2f(-LOG2E * x)); }
__device__ __forceinline__ float gelu_tanh(float x) {
    const float u = x * (1.0f + 0.044715f * x * x);
    return x * __builtin_amdgcn_rcpf(1.0f + __builtin_amdgcn_exp2f(-2.302208198f * u));
}
__device__ __forceinline__ int opaque_tid() { int t = threadIdx.x; asm volatile("" : "+v"(t)); return t; }
__device__ __forceinline__ float shx(float v, int lane, int o) { return __builtin_bit_cast(float, __builtin_amdgcn_ds_bpermute((lane ^ o) << 2, __builtin_bit_cast(int, v))); }
__device__ __forceinline__ float wave_sum(float v, int lane) {
#pragma unroll
    for (int o = 32; o >= 1; o >>= 1) v += shx(v, lane, o);
    return v;
}

namespace pg8 {
constexpr int BM = 256, BK = 64, HALF = 128, HTB = HALF * BK * 2, STAGE_BYTES = 8 * HTB, NXCD = 8, WGM = 8;
__host__ __device__ __forceinline__ int lds_byte(int r, int c) { const int st = (r >> 4) * 2 + (c >> 5), rr = r & 15, cc = c & 31, ob = rr * 64 + cc * 2; return st * 1024 + (ob ^ (((ob >> 9) & 1) << 5)); }
__host__ __device__ __forceinline__ void stage_rc(int b, int& R, int& C) { const int st = b / 1024, sb = b % 1024, swz = sb ^ (((sb >> 9) & 1) << 5); R = (st >> 1) * 16 + swz / 64; C = (st & 1) * 32 + (swz % 64) / 2; }
__host__ __device__ __forceinline__ int perm32(int rho) { const int n = rho >> 4, i = rho & 15; return 8 * (i >> 2) + 4 * n + (i & 3); }

struct Unit { int pm, pn, ak, bk, nt, kind; };
struct Gemm { const bf16_t* A; const bf16_t* Bt; int lda, ldb; };

__host__ __device__ __forceinline__ void tile_map(int nM, int nN, int L, int& pm, int& pn) {
    const int nwg = nM * nN; int wgid = L;
    { const int q = nwg / NXCD, r = nwg % NXCD, xcd = wgid % NXCD, off = wgid / NXCD; wgid = (xcd < r ? xcd * (q + 1) : r * (q + 1) + (xcd - r) * q) + off; }
    const int nig = WGM * nN, gid = wgid / nig, fm = gid * WGM, gsz = (nM - fm) < WGM ? (nM - fm) : WGM;
    pm = fm + ((wgid % nig) % gsz); pn = (wgid % nig) / gsz;
}
struct XInfo { int xi, nx, r, cnt, nbx; };
struct StaticOrder {
    XInfo X; int nN, nwg, nt, ak, bk;
    __device__ void init(const XInfo& X_, int N, int nt_, int ak_ = 0, int bk_ = 0) { X = X_; nN = N / BM; nwg = 8 * X.nbx * nN; nt = nt_; ak = ak_; bk = bk_; }
    __device__ __forceinline__ bool next(int i, Unit& u) const {
        const int t = i * X.cnt + X.r; if (t >= nwg) return false;
        const int nig = WGM * nN, gid = t / nig, q = t - gid * nig, pml = gid * WGM + (q & 7);
        u.pn = q >> 3; u.pm = (X.xi + (pml >> 3) * X.nx) * 8 + (pml & 7); u.ak = ak; u.bk = bk; u.nt = nt; u.kind = 0; return true;
    }
};
struct MergeOrder {
    XInfo X; int nwg;
    __device__ void init(const XInfo& X_) { X = X_; nwg = 8 * X.nbx * 4; }
    __device__ __forceinline__ bool next(int i, Unit& u) const {
        const int ti = i / 6, st = i - ti * 6, t = ti * X.cnt + X.r; if (t >= nwg) return false;
        const int nig = WGM * 4, gid = t / nig, q = t - gid * nig, pml = gid * WGM + (q & 7), n = st >> 1;
        u.pn = q >> 3; u.pm = (X.xi + (pml >> 3) * X.nx) * 8 + (pml & 7);
        if ((st & 1) == 0) { u.ak = 0; u.bk = n * 1024; u.nt = 16; } else { u.ak = 1024 + n * 512; u.bk = 3072 + n * 512; u.nt = 8; }
        u.kind = st; return true;
    }
};

struct EpiIn {
    static constexpr bool PERM = true;
    bf16_t* O;
    __device__ __forceinline__ void operator()(const f32x4 (&acc)[2][2][4][2], const Unit& u, int wr, int wc, int fr, int fq) const {
        const int row0 = u.pm * BM + wr * 64 + fr, col0 = u.pn * BM + wc * 32 + 8 * fq;
        const int mode = u.pn < 4 ? 1 : (u.pn < 6 ? 2 : 0);
#pragma unroll
        for (int ai = 0; ai < 2; ++ai)
#pragma unroll
            for (int m = 0; m < 4; ++m) { bf16_t* rowp = O + (size_t)(row0 + ai * HALF + m * 16) * MID_LD + col0;
#pragma unroll
                for (int bj = 0; bj < 2; ++bj) { f32x4 v0 = acc[ai][bj][m][0], v1 = acc[ai][bj][m][1];
                    if (mode == 1) {
#pragma unroll
                        for (int e = 0; e < 4; ++e) { v0[e] = gelu_tanh(v0[e]); v1[e] = gelu_tanh(v1[e]); }
                    } else if (mode == 2) { v0 = v0 * 0.125f; v1 = v1 * 0.125f; }
                    u32x4 w; w.x = pk2(v0[0], v0[1]); w.y = pk2(v0[2], v0[3]); w.z = pk2(v1[0], v1[1]); w.w = pk2(v1[2], v1[3]);
                    *(u32x4*)(rowp + bj * HALF) = w; } }
    }
};
struct EpiRes {
    static constexpr bool PERM = false;
    const float* xs; float* out; const float* gate;
    __device__ __forceinline__ void operator()(const f32x4 (&acc)[2][2][4][2], const Unit& u, int wr, int wc, int fr, int fq) const {
        const int row0 = u.pm * BM + wr * 64 + fr, col0 = u.pn * BM + wc * 32 + 4 * fq;
        const float* gp = gate + (size_t)(u.pm >> 3) * NMOD + col0;
        f32x4 gv[2][2];
#pragma unroll
        for (int bj = 0; bj < 2; ++bj)
#pragma unroll
            for (int n = 0; n < 2; ++n) gv[bj][n] = *(const f32x4*)(gp + bj * HALF + n * 16);
#pragma unroll
        for (int ai = 0; ai < 2; ++ai)
#pragma unroll
            for (int m = 0; m < 4; ++m) { const size_t off = (size_t)(row0 + ai * HALF + m * 16) * DM + col0;
#pragma unroll
                for (int bj = 0; bj < 2; ++bj)
#pragma unroll
                    for (int n = 0; n < 2; ++n) { const f32x4 xv = *(const f32x4*)(xs + off + bj * HALF + n * 16);
                        *(f32x4*)(out + off + bj * HALF + n * 16) = xv + gv[bj][n] * acc[ai][bj][m][n]; }
                if (m & 1) asm volatile("" ::: "memory"); }
    }
};
struct EpiFfn {
    static constexpr bool PERM = true;
    bf16_t* O;
    __device__ __forceinline__ void operator()(const f32x4 (&acc)[2][2][4][2], const Unit& u, int wr, int wc, int fr, int fq) const {
        const int row0 = u.pm * BM + wr * 64 + fr, col0 = u.pn * HALF + wc * 32 + 8 * fq;
#pragma unroll
        for (int ai = 0; ai < 2; ++ai)
#pragma unroll
            for (int m = 0; m < 4; ++m) { bf16_t* rowp = O + (size_t)(row0 + ai * HALF + m * 16) * MID_LD + col0;
                f32x4 r[2];
#pragma unroll
                for (int n = 0; n < 2; ++n) { const f32x4 g = acc[ai][0][m][n], up = acc[ai][1][m][n];
#pragma unroll
                    for (int e = 0; e < 4; ++e) r[n][e] = g[e] * fast_sigmoid(g[e]) * up[e]; }
                u32x4 w; w.x = pk2(r[0][0], r[0][1]); w.y = pk2(r[0][2], r[0][3]); w.z = pk2(r[1][0], r[1][1]); w.w = pk2(r[1][2], r[1][3]);
                *(u32x4*)rowp = w; }
    }
};
struct EpiMerge {
    static constexpr bool PERM = true;
    u32x4* gs; f32x4* ms; bf16_t* O;
    __device__ __forceinline__ void operator()(const f32x4 (&acc)[2][2][4][2], const Unit& u, int wr, int wc, int fr, int fq) const {
        const int tid = opaque_tid(), kind = u.kind;
        if ((kind & 1) == 0) {
#pragma unroll
            for (int ai = 0; ai < 2; ++ai)
#pragma unroll
                for (int bj = 0; bj < 2; ++bj)
#pragma unroll
                    for (int m = 0; m < 4; ++m) { const int j = (ai * 2 + bj) * 4 + m; f32x4 v0 = acc[ai][bj][m][0], v1 = acc[ai][bj][m][1];
#pragma unroll
                        for (int e = 0; e < 4; ++e) { v0[e] = fast_sigmoid(v0[e]); v1[e] = fast_sigmoid(v1[e]); }
                        u32x4 w; w.x = pk2(v0[0], v0[1]); w.y = pk2(v0[2], v0[3]); w.z = pk2(v1[0], v1[1]); w.w = pk2(v1[2], v1[3]);
                        gs[j * 512 + tid] = w; }
        } else {
            const int row0 = u.pm * BM + wr * 64 + fr, col0 = u.pn * BM + wc * 32 + 8 * fq;
#pragma unroll
            for (int ai = 0; ai < 2; ++ai)
#pragma unroll
                for (int bj = 0; bj < 2; ++bj) {
#pragma unroll
                    for (int m = 0; m < 4; ++m) { const int j = (ai * 2 + bj) * 4 + m; const u32x4 gw = gs[j * 512 + tid];
                        f32x4 p0 = acc[ai][bj][m][0], p1 = acc[ai][bj][m][1];
                        p0[0] *= bflo(gw.x); p0[1] *= bfhi(gw.x); p0[2] *= bflo(gw.y); p0[3] *= bfhi(gw.y);
                        p1[0] *= bflo(gw.z); p1[1] *= bfhi(gw.z); p1[2] *= bflo(gw.w); p1[3] *= bfhi(gw.w);
                        if (kind != 1) { p0 += ms[(2 * j) * 512 + tid]; p1 += ms[(2 * j + 1) * 512 + tid]; }
                        if (kind != 5) { ms[(2 * j) * 512 + tid] = p0; ms[(2 * j + 1) * 512 + tid] = p1; }
                        else { u32x4 w; w.x = pk2(p0[0], p0[1]); w.y = pk2(p0[2], p0[3]); w.z = pk2(p1[0], p1[1]); w.w = pk2(p1[2], p1[3]);
                            *(u32x4*)(O + (size_t)(row0 + ai * HALF + m * 16) * DM + col0 + bj * HALF) = w; }
                        if (m & 1) asm volatile("" ::: "memory"); } }
        }
    }
};

template <class Epi, class Sched, bool ALIGN_EPI = true>
__device__ __forceinline__ void gemm_phase(LAS unsigned char* lds, const Gemm g, const Sched& S, const Epi& E) {
    const int tid = opaque_tid(), wid = __builtin_amdgcn_readfirstlane(tid >> 6), lane = tid & 63, wr = wid >> 2, wc = wid & 3, fr = lane & 15, fq = lane >> 4;
    unsigned voffA[2], voffB[2];
#pragma unroll
    for (int i = 0; i < 2; ++i) { int R, C; stage_rc(tid * 16 + i * 8192, R, C); const int Rb = Epi::PERM ? ((R & ~31) + perm32(R & 31)) : R;
        voffA[i] = (unsigned)(R * g.lda + C) * 2u; voffB[i] = (unsigned)(Rb * g.ldb + C) * 2u; }
    const size_t kstep = (size_t)(BK * 2);
    const size_t hstepA = (size_t)HALF * g.lda * 2, hstepB = (size_t)HALF * g.ldb * 2;
    const size_t tstepA = 2 * hstepA, tstepB = 2 * hstepB;
    const unsigned ldsw = (unsigned)wid * 1024u;
    const int aoff = lds_byte(wr * 64 + fr, fq * 8), boff = lds_byte(wc * 32 + fr, fq * 8);
#define PG8_SA(b, h) (((b) * 2 + (h)) * HTB)
#define PG8_SB(b, h) ((4 + (b) * 2 + (h)) * HTB)
#define PG8_STAGE(bufoff, gbase, voff) do { _Pragma("unroll") for (int _i = 0; _i < 2; ++_i) \
        __builtin_amdgcn_global_load_lds((const unsigned*)((const char*)(gbase) + (voff)[_i]), (LAS unsigned*)(lds + (bufoff) + ldsw + _i * 8192), 16, 0, 0); } while (0)
#define PG8_LDA(dst, b, h) do { _Pragma("unroll") for (int m = 0; m < 4; ++m) _Pragma("unroll") for (int k = 0; k < 2; ++k) dst[m][k] = *(const LAS bf16x8*)(lds + PG8_SA(b, h) + aoff + m * 2048 + k * 1024); } while (0)
#define PG8_LDB(dst, b, h) do { _Pragma("unroll") for (int n = 0; n < 2; ++n) _Pragma("unroll") for (int k = 0; k < 2; ++k) dst[n][k] = *(const LAS bf16x8*)(lds + PG8_SB(b, h) + boff + n * 2048 + k * 1024); } while (0)
#define PG8_MMA(ai, bj, At, Bt) do { __builtin_amdgcn_s_setprio(1); _Pragma("unroll") for (int m = 0; m < 4; ++m) _Pragma("unroll") for (int n = 0; n < 2; ++n) _Pragma("unroll") for (int k = 0; k < 2; ++k) \
        acc[ai][bj][m][n] = __builtin_amdgcn_mfma_f32_16x16x32_bf16(Bt[n][k], At[m][k], acc[ai][bj][m][n], 0, 0, 0); __builtin_amdgcn_s_setprio(0); } while (0)
#define PG8_WAIT_V(n) asm volatile("s_waitcnt vmcnt(" #n ")" ::: "memory")
#define PG8_WAIT_L(n) asm volatile("s_waitcnt lgkmcnt(" #n ")" ::: "memory")
#define PG8_BAR __builtin_amdgcn_s_barrier()
#define PG8_SCHED __builtin_amdgcn_sched_barrier(0)
    Unit cur, nxt; int ui = 0;
    if (!S.next(0, cur)) return;
    f32x4 acc[2][2][4][2];
#pragma unroll
    for (int a = 0; a < 2; ++a)
#pragma unroll
        for (int b = 0; b < 2; ++b)
#pragma unroll
            for (int m = 0; m < 4; ++m)
#pragma unroll
                for (int n = 0; n < 2; ++n) acc[a][b][m][n] = (f32x4){0.f, 0.f, 0.f, 0.f};
    bf16x8 At[4][2], B0[2][2], B1[2][2];
    const char* cA = (const char*)g.A + (size_t)cur.pm * tstepA + (size_t)cur.ak * 2; const char* cB = (const char*)g.Bt + (size_t)cur.pn * tstepB + (size_t)cur.bk * 2;
    PG8_STAGE(PG8_SB(0, 0), cB, voffB); PG8_STAGE(PG8_SB(0, 1), cB + hstepB, voffB); PG8_STAGE(PG8_SA(0, 0), cA, voffA); PG8_STAGE(PG8_SA(0, 1), cA + hstepA, voffA);
    if (wr == 1) PG8_BAR;
    PG8_WAIT_V(2); PG8_BAR;
    PG8_STAGE(PG8_SB(1, 0), cB + kstep, voffB); PG8_STAGE(PG8_SA(1, 0), cA + kstep, voffA); PG8_STAGE(PG8_SB(1, 1), cB + hstepB + kstep, voffB);
    PG8_WAIT_V(6); PG8_BAR;
    for (;;) {
        const bool has_next = S.next(ui + 1, nxt);
        const char* nA = has_next ? (const char*)g.A + (size_t)nxt.pm * tstepA + (size_t)nxt.ak * 2 : cA;
        const char* nB = has_next ? (const char*)g.Bt + (size_t)nxt.pn * tstepB + (size_t)nxt.bk * 2 : cB;
        const int nt = cur.nt;
        for (int t = 0; t < nt; t += 2) {
            const bool last = (t == nt - 2);
            const char* a1 = cA + (size_t)(t + 1) * kstep;
            const char* a2 = last ? nA : cA + (size_t)(t + 2) * kstep; const char* b2 = last ? nB : cB + (size_t)(t + 2) * kstep;
            const char* a3 = a2 + kstep; const char* b3 = b2 + kstep;
            PG8_LDB(B0, 0, 0); PG8_LDB(B1, 0, 1); PG8_SCHED; PG8_LDA(At, 0, 0); PG8_STAGE(PG8_SA(1, 1), a1 + hstepA, voffA);
            PG8_WAIT_V(8); PG8_WAIT_L(0); PG8_BAR; PG8_MMA(0, 0, At, B0); PG8_MMA(0, 1, At, B1); PG8_BAR; PG8_SCHED;
            PG8_LDA(At, 0, 1); PG8_STAGE(PG8_SB(0, 0), b2, voffB); PG8_STAGE(PG8_SB(0, 1), b2 + hstepB, voffB); PG8_STAGE(PG8_SA(0, 0), a2, voffA);
            PG8_WAIT_V(8); PG8_WAIT_L(0); PG8_BAR; PG8_MMA(1, 0, At, B0); PG8_MMA(1, 1, At, B1); PG8_BAR; PG8_SCHED;
            PG8_LDB(B0, 1, 0); PG8_LDB(B1, 1, 1); PG8_SCHED; PG8_LDA(At, 1, 0); PG8_STAGE(PG8_SA(0, 1), a2 + hstepA, voffA);
            PG8_WAIT_V(8); PG8_WAIT_L(0); PG8_BAR; PG8_MMA(0, 0, At, B0); PG8_MMA(0, 1, At, B1); PG8_BAR; PG8_SCHED;
            PG8_LDA(At, 1, 1); PG8_STAGE(PG8_SB(1, 0), b3, voffB); PG8_STAGE(PG8_SB(1, 1), b3 + hstepB, voffB); PG8_STAGE(PG8_SA(1, 0), a3, voffA);
            PG8_WAIT_V(8); PG8_WAIT_L(0); PG8_BAR; PG8_MMA(1, 0, At, B0); PG8_MMA(1, 1, At, B1); PG8_BAR; PG8_SCHED;
        }
        if constexpr (ALIGN_EPI) { if (wr == 0) PG8_BAR; }
        E(acc, cur, wr, wc, fr, fq);
        if (!has_next) break;
#pragma unroll
        for (int a = 0; a < 2; ++a)
#pragma unroll
            for (int b = 0; b < 2; ++b)
#pragma unroll
                for (int m = 0; m < 4; ++m)
#pragma unroll
                    for (int n = 0; n < 2; ++n) acc[a][b][m][n] = (f32x4){0.f, 0.f, 0.f, 0.f};
        cur = nxt; cA = nA; cB = nB; ++ui;
        if constexpr (ALIGN_EPI) { if (wr == 1) PG8_BAR; }
    }
    PG8_WAIT_V(0);
    if constexpr (!ALIGN_EPI) { if (wr == 0) PG8_BAR; }
    PG8_BAR;
#undef PG8_SA
#undef PG8_SB
#undef PG8_STAGE
#undef PG8_LDA
#undef PG8_LDB
#undef PG8_MMA
#undef PG8_WAIT_V
#undef PG8_WAIT_L
#undef PG8_BAR
#undef PG8_SCHED
}
}

struct Params { const float* in[18]; float* out; unsigned char* ws; int ph_lo, ph_hi, coop, pad; };
enum { I_X = 0, I_C, I_G1, I_G2, I_WADA, I_BADA, I_WIN, I_LNG, I_LNB, I_WSP, I_BSP, I_PW, I_PS, I_WBR, I_WOUT, I_WFI, I_WFO, I_FG };

#define MFMA32(a, b, c) __builtin_amdgcn_mfma_f32_32x32x16_bf16(a, b, c, 0, 0, 0)
typedef short v4i16_t __attribute__((ext_vector_type(4)));
__device__ __forceinline__ s16x4 tr_read(LAS const unsigned char* p) { return __builtin_bit_cast(s16x4, __builtin_amdgcn_ds_read_tr16_b64_v4i16((LAS v4i16_t*)p)); }
__device__ __forceinline__ bf16x8 cat8(s16x4 a, s16x4 b) { bf16x8 r; r[0] = a[0]; r[1] = a[1]; r[2] = a[2]; r[3] = a[3]; r[4] = b[0]; r[5] = b[1]; r[6] = b[2]; r[7] = b[3]; return r; }

__device__ __forceinline__ void transpose_tile(LAS float* tl, const float* src, int ld, bf16_t* dst, int ldd) {
    const int tid = opaque_tid();
    { const int r = tid >> 4, c4 = (tid & 15) * 4;
#pragma unroll
      for (int h = 0; h < 2; ++h) { const int k = r + 32 * h; const f32x4 v = *(const f32x4*)(src + (size_t)k * ld + c4);
          tl[k * 65 + c4] = v[0]; tl[k * 65 + c4 + 1] = v[1]; tl[k * 65 + c4 + 2] = v[2]; tl[k * 65 + c4 + 3] = v[3]; } }
    __syncthreads();
    { const int n = tid >> 3, k8 = (tid & 7) * 8; float v[8];
#pragma unroll
      for (int j = 0; j < 8; ++j) v[j] = tl[(k8 + j) * 65 + n];
      u32x4 w; w.x = pk2(v[0], v[1]); w.y = pk2(v[2], v[3]); w.z = pk2(v[4], v[5]); w.w = pk2(v[6], v[7]);
      *(u32x4*)(dst + (size_t)n * ldd + k8) = w; }
    __syncthreads();
}

__device__ __forceinline__ void p0_prologue(const Params& p, LAS unsigned char* lds) {
    const int tid = opaque_tid(), G = gridDim.x, bid = blockIdx.x;
    unsigned char* ws = p.ws;
    bf16_t* WIN = (bf16_t*)(ws + WS_WIN); bf16_t* WMG = (bf16_t*)(ws + WS_WMG); bf16_t* WOUT = (bf16_t*)(ws + WS_WOUT);
    bf16_t* WFI = (bf16_t*)(ws + WS_WFI); bf16_t* WFO = (bf16_t*)(ws + WS_WFO); bf16_t* WPT = (bf16_t*)(ws + WS_WPT); bf16_t* WSP = (bf16_t*)(ws + WS_WSP);
    LAS float* tl = (LAS float*)lds;
    constexpr int TPL = 4304;
    for (int J = bid; J < NL * TPL; J += G) {
        const int l = J / TPL; int j = J - l * TPL;
        const float* src; int ld; bf16_t* dst; int ldd;
        if (j < 768) { const int kt = j / 48, ntile = j % 48;
            src = p.in[I_WIN] + ((size_t)l * DM + kt * 64) * 6144 + ntile * 64; ld = 6144; dst = WIN + ((size_t)l * 3072 + ntile * 64) * DM + kt * 64; ldd = DM; }
        else if (j < 1536) { j -= 768; const int kt = j / 48, ntile = j % 48, br = ntile >> 4, n0 = (ntile & 15) * 64;
            src = p.in[I_WIN] + ((size_t)l * DM + kt * 64) * 6144 + 3072 + ntile * 64; ld = 6144; dst = WMG + ((size_t)l * DM + n0) * WMG_LD + br * 1024 + kt * 64; ldd = WMG_LD; }
        else if (j < 1920) { j -= 1536; const int br = j >> 7, r = j & 127, kt = r >> 4, ntile = r & 15;
            src = p.in[I_WBR] + ((size_t)(l * 3 + br) * BW + kt * 64) * DM + ntile * 64; ld = DM; dst = WMG + ((size_t)l * DM + ntile * 64) * WMG_LD + 3072 + br * 512 + kt * 64; ldd = WMG_LD; }
        else if (j < 2176) { j -= 1920; const int kt = j >> 4, ntile = j & 15;
            src = p.in[I_WOUT] + ((size_t)l * DM + kt * 64) * DM + ntile * 64; ld = DM; dst = WOUT + ((size_t)l * DM + ntile * 64) * DM + kt * 64; ldd = DM; }
        else if (j < 3584) { j -= 2176; const int kt = j / 88, ntile = j % 88, c0 = ntile * 64; const bool up = c0 >= FF; const int f0 = up ? c0 - FF : c0;
            const int np = 256 * (f0 >> 7) + (f0 & 127) + (up ? 128 : 0);
            src = p.in[I_WFI] + ((size_t)l * DM + kt * 64) * (2 * FF) + c0; ld = 2 * FF; dst = WFI + ((size_t)l * (2 * FF) + np) * DM + kt * 64; ldd = DM; }
        else if (j < 4288) { j -= 3584; const int kt = j >> 4, ntile = j & 15;
            src = p.in[I_WFO] + ((size_t)l * FF + kt * 64) * DM + ntile * 64; ld = DM; dst = WFO + ((size_t)l * DM + ntile * 64) * FF + kt * 64; ldd = FF; }
        else { j -= 4288; const int gg = j >> 2, r = j & 3, kt = r >> 1, ntile = r & 1;
            src = p.in[I_PW] + ((size_t)(l * 4 + gg) * 128 + kt * 64) * 128 + ntile * 64; ld = 128; dst = WPT + ((size_t)(l * 4 + gg) * 128 + ntile * 64) * 128 + kt * 64; ldd = 128; }
        transpose_tile(tl, src, ld, dst, ldd);
    }
    for (int idx = bid * 512 + tid; idx < NL * 4 * 128 * 128; idx += G * 512) { const int t = (idx >> 7) & 127, s = idx & 127; WSP[idx] = (s <= t) ? (bf16_t)f2bf(p.in[I_WSP][idx]) : (bf16_t)0; }
    LAS float* ca = (LAS float*)lds;
    float* MOD = (float*)(ws + WS_MOD);
    for (int cgp = bid; cgp < (NL * NMOD) / 96; cgp += G) {
        __syncthreads();
        for (int i = tid; i < NB * DM; i += 512) { const int b = i >> 10, k = i & 1023; const float cv = p.in[I_C][i]; ca[k * 32 + b] = cv * fast_sigmoid(cv); }
        __syncthreads();
        const int cj = tid & 31, ks = tid >> 5;
        float acc[3][32];
#pragma unroll
        for (int q = 0; q < 3; ++q)
#pragma unroll
            for (int b = 0; b < 32; ++b) acc[q][b] = 0.f;
        const int colg = cgp * 96;
        const int l = colg / NMOD, cl = colg - l * NMOD;
        const float* wa = p.in[I_WADA] + (size_t)l * DM * NMOD + cl + cj;
        for (int k = ks * 64; k < ks * 64 + 64; ++k) {
            float w[3];
#pragma unroll
            for (int q = 0; q < 3; ++q) w[q] = wa[(size_t)k * NMOD + q * 32];
            f32x4 cv[8];
#pragma unroll
            for (int i = 0; i < 8; ++i) cv[i] = *(const LAS f32x4*)(ca + k * 32 + i * 4);
#pragma unroll
            for (int q = 0; q < 3; ++q)
#pragma unroll
                for (int b = 0; b < 32; ++b) acc[q][b] += cv[b >> 2][b & 3] * w[q];
        }
        LAS float* red = (LAS float*)lds;
#pragma unroll
        for (int q = 0; q < 3; ++q) {
            __syncthreads();
#pragma unroll
            for (int b = 0; b < 32; ++b) red[(ks * 32 + b) * 32 + cj] = acc[q][b];
            __syncthreads();
            for (int o = tid; o < 1024; o += 512) { const int b = o >> 5, c = o & 31; float s = 0.f;
#pragma unroll
                for (int k2 = 0; k2 < 16; ++k2) s += red[(k2 * 32 + b) * 32 + c];
                const int col = cl + q * 32 + c;
                MOD[((size_t)l * NB + b) * NMOD + col] = s + p.in[I_BADA][(size_t)l * NMOD + col]; }
        }
    }
    __syncthreads();
}

__device__ __forceinline__ void norm_phase(const pg8::XInfo& X, const float* xs, const float* g, const float* modl, int shoff, int scoff, bf16_t* act) {
    const int tid_ = opaque_tid(), lane = tid_ & 63, wid = tid_ >> 6;
    for (int blk = X.r * 8 + wid; blk < X.nbx * 64; blk += X.cnt * 8) {
        const int b = X.xi + (blk >> 6) * X.nx, row0 = b * SEQ + (blk & 63) * 32;
        f32x4 ga[4], sh[4];
#pragma unroll
        for (int j = 0; j < 4; ++j) { const int col = j * 256 + lane * 4; const f32x4 gv = *(const f32x4*)(g + col), sc = *(const f32x4*)(modl + (size_t)b * NMOD + scoff + col);
            ga[j] = gv * (1.0f + sc); sh[j] = *(const f32x4*)(modl + (size_t)b * NMOD + shoff + col); }
#pragma unroll 2
        for (int r = 0; r < 32; ++r) {
            const float* xr = xs + (size_t)(row0 + r) * DM + lane * 4;
            f32x4 x[4]; float ss = 0.f;
#pragma unroll
            for (int j = 0; j < 4; ++j) { x[j] = *(const f32x4*)(xr + j * 256); ss += x[j][0] * x[j][0] + x[j][1] * x[j][1] + x[j][2] * x[j][2] + x[j][3] * x[j][3]; }
            ss = wave_sum(ss, lane);
            const float rstd = 1.0f / sqrtf(ss * (1.0f / DM) + EPS);
            bf16_t* orow = act + (size_t)(row0 + r) * ACT_LD + lane * 4;
#pragma unroll
            for (int j = 0; j < 4; ++j) { const f32x4 y = x[j] * rstd * ga[j] + sh[j]; u32x2 w; w.x = pk2(y[0], y[1]); w.y = pk2(y[2], y[3]); *(u32x2*)(orow + j * 256) = w; }
        }
    }
}
__device__ __forceinline__ void final_norm(const pg8::XInfo& X, float* x, const float* g) {
    const int tid_ = opaque_tid(), lane = tid_ & 63, wid = tid_ >> 6;
    f32x4 gv[4];
#pragma unroll
    for (int j = 0; j < 4; ++j) gv[j] = *(const f32x4*)(g + j * 256 + lane * 4);
    for (int rl = X.r * 8 + wid; rl < X.nbx * SEQ; rl += X.cnt * 8) {
        const int row = (X.xi + (rl >> 11) * X.nx) * SEQ + (rl & 2047);
        float* xr = x + (size_t)row * DM + lane * 4;
        f32x4 v[4]; float ss = 0.f;
#pragma unroll
        for (int j = 0; j < 4; ++j) { v[j] = *(const f32x4*)(xr + j * 256); ss += v[j][0] * v[j][0] + v[j][1] * v[j][1] + v[j][2] * v[j][2] + v[j][3] * v[j][3]; }
        ss = wave_sum(ss, lane);
        const float rstd = 1.0f / sqrtf(ss * (1.0f / DM) + EPS);
#pragma unroll
        for (int j = 0; j < 4; ++j) *(f32x4*)(xr + j * 256) = v[j] * rstd * gv[j];
    }
}

__device__ __forceinline__ void gmlp_unit(LAS unsigned char* lds, int b, int ch, const bf16_t* mid, const bf16_t* wsp, const float* lng, const float* lnb, const float* bsp, bf16_t* act) {
    const int tid = opaque_tid(), lane = tid & 63, wid = tid >> 6;
    const int row0 = b * SEQ + ch * 128;
    {
        const int s = tid >> 2, q = tid & 3;
        const bf16_t* vp = mid + (size_t)(row0 + s) * MID_LD + 512 + q * 8;
        float sum = 0.f, sq = 0.f;
#pragma unroll 4
        for (int i = 0; i < 16; ++i) { const u32x4 v = *(const u32x4*)(vp + i * 32);
            const float a0 = bflo(v.x), a1 = bfhi(v.x), a2 = bflo(v.y), a3 = bfhi(v.y), a4 = bflo(v.z), a5 = bfhi(v.z), a6 = bflo(v.w), a7 = bfhi(v.w);
            sum += ((a0 + a1) + (a2 + a3)) + ((a4 + a5) + (a6 + a7));
            sq += ((a0 * a0 + a1 * a1) + (a2 * a2 + a3 * a3)) + ((a4 * a4 + a5 * a5) + (a6 * a6 + a7 * a7)); }
        sum += shx(sum, lane, 1); sum += shx(sum, lane, 2);
        sq += shx(sq, lane, 1); sq += shx(sq, lane, 2);
        const float mean = sum * (1.0f / BW);
        const float var = fmaxf(sq * (1.0f / BW) - mean * mean, 0.f);
        const float rstd = 1.0f / sqrtf(var + EPS);
#pragma unroll 2
        for (int i = 0; i < 16; ++i) {
            const int c = (4 * i + q) * 8;
            const u32x4 v = *(const u32x4*)(vp + i * 32);
            const f32x4 g0 = *(const f32x4*)(lng + c), g1 = *(const f32x4*)(lng + c + 4), b0 = *(const f32x4*)(lnb + c), b1 = *(const f32x4*)(lnb + c + 4);
            u32x4 w;
            w.x = pk2((bflo(v.x) - mean) * rstd * g0[0] + b0[0], (bfhi(v.x) - mean) * rstd * g0[1] + b0[1]);
            w.y = pk2((bflo(v.y) - mean) * rstd * g0[2] + b0[2], (bfhi(v.y) - mean) * rstd * g0[3] + b0[3]);
            w.z = pk2((bflo(v.z) - mean) * rstd * g1[0] + b1[0], (bfhi(v.z) - mean) * rstd * g1[1] + b1[1]);
            w.w = pk2((bflo(v.w) - mean) * rstd * g1[2] + b1[2], (bfhi(v.w) - mean) * rstd * g1[3] + b1[3]);
            *(LAS u32x4*)(lds + i * 8192 + s * 64 + q * 16) = w;
        }
    }
    __syncthreads();
    {
        const int g = wid >> 1, hh = lane >> 5, l32 = lane & 31, i16 = lane & 15, g16 = lane >> 4;
        const unsigned troff = (unsigned)((4 * hh + (i16 >> 2)) * 64 + (16 * (g16 & 1) + 4 * (i16 & 3)) * 2);
#pragma unroll 1
        for (int nti = 0; nti < 2; ++nti) {
            const int nt = (wid & 1) ? (1 + nti) : (nti * 3);
            f32x16 acc[4];
#pragma unroll
            for (int mt = 0; mt < 4; ++mt)
#pragma unroll
                for (int e = 0; e < 16; ++e) acc[mt][e] = 0.f;
            const bf16_t* wrow = wsp + (size_t)(g * 128 + nt * 32 + l32) * 128 + 4 * hh;
            const int nkk = 2 * nt + 2;
            bf16x8 bfr[8];
#pragma unroll
            for (int kk = 0; kk < 8; ++kk) {
                u32x4 bw = {0u, 0u, 0u, 0u};
                if (kk < nkk) { const u32x2 lo = *(const u32x2*)(wrow + kk * 16), hi = *(const u32x2*)(wrow + kk * 16 + 8); bw.x = lo.x; bw.y = lo.y; bw.z = hi.x; bw.w = hi.y; }
                bfr[kk] = __builtin_bit_cast(bf16x8, bw);
            }
#pragma unroll
            for (int kk = 0; kk < 8; ++kk) {
                if (kk < nkk) {
#pragma unroll
                    for (int mt = 0; mt < 4; ++mt) {
                        LAS const unsigned char* ap = lds + (4 * g + mt) * 8192 + kk * 1024 + troff;
                        const bf16x8 afrag = cat8(tr_read(ap), tr_read(ap + 512));
                        acc[mt] = MFMA32(afrag, bfr[kk], acc[mt]);
                    }
                }
            }
            const int t = nt * 32 + l32; const size_t row = (size_t)(row0 + t);
            const float bs = bsp[g * 128 + t];
#pragma unroll
            for (int mt = 0; mt < 4; ++mt)
#pragma unroll
                for (int a = 0; a < 4; ++a) {
                    const int c0 = g * 128 + mt * 32 + a * 8 + 4 * hh;
                    const u32x2 uu = *(const u32x2*)(mid + row * MID_LD + c0);
                    u32x2 w;
                    w.x = pk2(bflo(uu.x) * (acc[mt][4 * a + 0] + bs), bfhi(uu.x) * (acc[mt][4 * a + 1] + bs));
                    w.y = pk2(bflo(uu.y) * (acc[mt][4 * a + 2] + bs), bfhi(uu.y) * (acc[mt][4 * a + 3] + bs));
                    *(u32x2*)(act + row * ACT_LD + 1024 + c0) = w;
                }
        }
    }
    __syncthreads();
}

__device__ __forceinline__ void pool_unit(LAS unsigned char* lds, int b, int tl, const bf16_t* mid, const bf16_t* wpt, const float* pscale, bf16_t* act) {
    const int tid = opaque_tid(), lane = tid & 63, wid = tid >> 6;
    const int row0 = b * SEQ + tl * 128, pos0 = tl * 128;
    const int hh = lane >> 5, l32 = lane & 31;
    LAS unsigned char* xa = lds;
    LAS unsigned char* dt = lds + 40960;
    u32x4 sv[5];
#define POOL_LOAD(gg) do { _Pragma("unroll") for (int k5 = 0; k5 < 5; ++k5) { const int item = tid + k5 * 512, r = item >> 4, chn = item & 15, pos = pos0 - 16 + r; \
            sv[k5] = (u32x4){0u, 0u, 0u, 0u}; \
            if (item < 144 * 16 && pos >= 0) sv[k5] = *(const u32x4*)(mid + (size_t)(row0 - 16 + r) * MID_LD + 2560 + (gg) * 128 + chn * 8); } } while (0)
    POOL_LOAD(0);
#pragma unroll
    for (int g = 0; g < 4; ++g) {
        const int w = 2 << g;
#pragma unroll
        for (int k5 = 0; k5 < 5; ++k5) { const int item = tid + k5 * 512, r = item >> 4, chn = item & 15; if (item < 144 * 16) *(LAS u32x4*)(xa + r * 272 + chn * 16) = sv[k5]; }
        __syncthreads();
        if (g < 3) POOL_LOAD(g + 1);
#pragma unroll 1
        for (int it = 0; it < 4; ++it) {
            const int item = tid + it * 512, t = item >> 4, chn = item & 15;
            const int pos = pos0 + t, cnt = (pos + 1 < w) ? pos + 1 : w;
            LAS const unsigned char* xp = xa + (t + 16) * 272 + chn * 16;
            const u32x4 x0 = *(const LAS u32x4*)xp;
            float a[8] = {0.f, 0.f, 0.f, 0.f, 0.f, 0.f, 0.f, 0.f};
#pragma unroll
            for (int j = 0; j < w; ++j) { const u32x4 xv = *(const LAS u32x4*)(xp - j * 272);
                a[0] += bflo(xv.x); a[1] += bfhi(xv.x); a[2] += bflo(xv.y); a[3] += bfhi(xv.y); a[4] += bflo(xv.z); a[5] += bfhi(xv.z); a[6] += bflo(xv.w); a[7] += bfhi(xv.w); }
            const float inv = 1.0f / (float)cnt;
            u32x4 o; o.x = pk2(a[0] * inv - bflo(x0.x), a[1] * inv - bfhi(x0.x)); o.y = pk2(a[2] * inv - bflo(x0.y), a[3] * inv - bfhi(x0.y));
            o.z = pk2(a[4] * inv - bflo(x0.z), a[5] * inv - bfhi(x0.z)); o.w = pk2(a[6] * inv - bflo(x0.w), a[7] * inv - bfhi(x0.w));
            *(LAS u32x4*)(dt + t * 272 + chn * 16) = o;
        }
        __syncthreads();
        {
            const int mt = wid & 3, nt0 = (wid >> 2) * 2;
            bf16x8 af[8];
            const bf16_t* ap = wpt + (size_t)(g * 128 + mt * 32 + l32) * 128 + 8 * hh;
#pragma unroll
            for (int kk = 0; kk < 8; ++kk) af[kk] = *(const bf16x8*)(ap + kk * 16);
#pragma unroll 1
            for (int nti = 0; nti < 2; ++nti) {
                const int nt = nt0 + nti;
                f32x16 acc;
#pragma unroll
                for (int e = 0; e < 16; ++e) acc[e] = 0.f;
                LAS const unsigned char* bp = dt + (nt * 32 + l32) * 272 + 16 * hh;
#pragma unroll
                for (int kk = 0; kk < 8; ++kk) { const bf16x8 bf = *(const LAS bf16x8*)(bp + kk * 32); acc = MFMA32(af[kk], bf, acc); }
                const size_t row = (size_t)(row0 + nt * 32 + l32);
#pragma unroll
                for (int a = 0; a < 4; ++a) { const int dd = g * 128 + mt * 32 + a * 8 + 4 * hh; const f32x4 sc = *(const f32x4*)(pscale + dd);
                    u32x2 o; o.x = pk2(acc[4 * a] * sc[0], acc[4 * a + 1] * sc[1]); o.y = pk2(acc[4 * a + 2] * sc[2], acc[4 * a + 3] * sc[3]);
                    *(u32x2*)(act + row * ACT_LD + 2048 + dd) = o; }
            }
        }
        __syncthreads();
    }
#undef POOL_LOAD
}

constexpr int ATT_SLOT = 8704, ATT_WIN = 13, ATT_BACK = 5, ATT_PRIV = ATT_WIN * ATT_SLOT;
static_assert(ATT_PRIV + 8 * 4096 <= LDS_BYTES, "attention LDS map");
__device__ __forceinline__ void attn_wg(LAS unsigned char* lds, int b, int h, int qb0, const bf16_t* mid, bf16_t* act, int tid) {
    const int lane = tid & 63, wid = __builtin_amdgcn_readfirstlane(tid >> 6);
    const int hh = lane >> 5, ql = lane & 31, i16 = lane & 15, g16 = lane >> 4;
    const int qb = qb0 + wid;
    const int win_lo = qb0 > ATT_BACK ? qb0 - ATT_BACK : 0, nwin = qb0 + 8 - win_lo;
    const size_t rowq = (size_t)b * SEQ + qb * 32 + ql;
    bf16x8 qf[4];
#pragma unroll
    for (int kk = 0; kk < 4; ++kk) qf[kk] = *(const bf16x8*)(mid + rowq * MID_LD + 1024 + h * 64 + kk * 16 + 8 * hh);
    {
        const int isv = tid >> 8, t8 = tid & 255, row = t8 >> 3, ch = t8 & 7;
        const bf16_t* src = mid + ((size_t)b * SEQ + row) * MID_LD + (isv ? 2048 : 1536) + h * 64 + ch * 8;
        const unsigned dsto = isv ? (unsigned)(4608 + (ch >> 2) * 2048 + row * 64 + (ch & 3) * 16) : (unsigned)(row * 144 + ch * 16);
        u32x4 v[ATT_WIN];
#pragma unroll
        for (int i = 0; i < ATT_WIN; ++i) if (i < nwin) v[i] = *(const u32x4*)(src + (size_t)(win_lo + i) * 32 * MID_LD);
#pragma unroll
        for (int i = 0; i < ATT_WIN; ++i) if (i < nwin) *(LAS u32x4*)(lds + i * ATT_SLOT + dsto) = v[i];
    }
    __syncthreads();
    f32x16 o0, o1;
#pragma unroll
    for (int e = 0; e < 16; ++e) { o0[e] = 0.f; o1[e] = 0.f; }
    float C = 1.0f;
    const unsigned troff = (unsigned)((4 * hh + (i16 >> 2)) * 64 + (16 * (g16 & 1) + 4 * (i16 & 3)) * 2);
    LAS unsigned char* vl = lds + ATT_PRIV + wid * 4096;
    const bf16_t* kbase = mid + ((size_t)b * SEQ + ql) * MID_LD + 1536 + h * 64 + 8 * hh;
    const bf16_t* vbase = mid + ((size_t)b * SEQ + ql) * MID_LD + 2048 + h * 64 + 8 * hh;
#pragma unroll 1
    for (int kt = qb; kt >= 0; --kt) {
        f32x16 s;
#pragma unroll
        for (int e = 0; e < 16; ++e) s[e] = 0.f;
        LAS const unsigned char* vimg;
        if (kt >= win_lo) {
            LAS const unsigned char* sl = lds + (kt - win_lo) * ATT_SLOT;
#pragma unroll
            for (int kk = 0; kk < 4; ++kk) { const bf16x8 kf = *(const LAS bf16x8*)(sl + ql * 144 + kk * 32 + hh * 16); s = MFMA32(kf, qf[kk], s); }
            vimg = sl + 4608;
        } else {
            bf16x8 kf[4]; u32x4 vv[4];
#pragma unroll
            for (int c = 0; c < 4; ++c) { kf[c] = *(const bf16x8*)(kbase + (size_t)kt * 32 * MID_LD + c * 16); vv[c] = *(const u32x4*)(vbase + (size_t)kt * 32 * MID_LD + c * 16); }
#pragma unroll
            for (int c = 0; c < 4; ++c) { const int chn = hh + 2 * c; *(LAS u32x4*)(vl + (chn >> 2) * 2048 + ql * 64 + (chn & 3) * 16) = vv[c]; }
#pragma unroll
            for (int kk = 0; kk < 4; ++kk) s = MFMA32(kf[kk], qf[kk], s);
            vimg = vl;
        }
        float bt[16], om[16];
        const bool diag = (kt == qb);
#pragma unroll
        for (int r = 0; r < 16; ++r) {
            const float e = __builtin_amdgcn_exp2f(fminf(s[r] * LOG2E, 100.0f));
            float o1_ = __builtin_amdgcn_rcpf(1.0f + e), b1 = e * o1_;
            const int keyl = 8 * (r >> 2) + 4 * hh + (r & 3);
            if (diag && keyl >= ql) { o1_ = 1.0f; b1 = 0.0f; }
            om[r] = o1_; bt[r] = b1;
        }
        float g4[4], pg[4];
#pragma unroll
        for (int a = 0; a < 4; ++a) g4[a] = (om[4 * a] * om[4 * a + 1]) * (om[4 * a + 2] * om[4 * a + 3]);
#pragma unroll
        for (int a = 0; a < 4; ++a) pg[a] = shx(g4[a], lane, 32);
        float after = 1.0f; float pa[16];
#pragma unroll
        for (int a = 3; a >= 0; --a) {
            const float s3 = C * after * (hh == 0 ? pg[a] : 1.0f), s2 = s3 * om[4 * a + 3], s1 = s2 * om[4 * a + 2], s0 = s1 * om[4 * a + 1];
            pa[4 * a + 3] = bt[4 * a + 3] * s3; pa[4 * a + 2] = bt[4 * a + 2] * s2; pa[4 * a + 1] = bt[4 * a + 1] * s1; pa[4 * a + 0] = bt[4 * a + 0] * s0;
            after *= g4[a] * pg[a];
        }
        C *= after;
#pragma unroll
        for (int kk2 = 0; kk2 < 2; ++kk2) {
            u32x4 pw; pw.x = pk2(pa[8 * kk2 + 0], pa[8 * kk2 + 1]); pw.y = pk2(pa[8 * kk2 + 2], pa[8 * kk2 + 3]); pw.z = pk2(pa[8 * kk2 + 4], pa[8 * kk2 + 5]); pw.w = pk2(pa[8 * kk2 + 6], pa[8 * kk2 + 7]);
            const bf16x8 pf = __builtin_bit_cast(bf16x8, pw);
            LAS const unsigned char* ap = vimg + kk2 * 1024 + troff;
            const bf16x8 a0 = cat8(tr_read(ap), tr_read(ap + 512));
            const bf16x8 a1 = cat8(tr_read(ap + 2048), tr_read(ap + 2048 + 512));
            o0 = MFMA32(a0, pf, o0); o1 = MFMA32(a1, pf, o1);
        }
        if (__all(C < 1.0e-38f)) break;
    }
    bf16_t* op = act + rowq * ACT_LD + 1536 + h * 64 + 4 * hh;
#pragma unroll
    for (int a = 0; a < 4; ++a) {
        u32x2 w0, w1; w0.x = pk2(o0[4 * a], o0[4 * a + 1]); w0.y = pk2(o0[4 * a + 2], o0[4 * a + 3]); w1.x = pk2(o1[4 * a], o1[4 * a + 1]); w1.y = pk2(o1[4 * a + 2], o1[4 * a + 3]);
        *(u32x2*)(op + a * 8) = w0; *(u32x2*)(op + 32 + a * 8) = w1;
    }
    __syncthreads();
}

__global__ void __launch_bounds__(512, 2) fwd_megakernel(Params p) {
    extern __shared__ __attribute__((aligned(16))) unsigned char lds_raw[];
    LAS unsigned char* lds = (LAS unsigned char*)lds_raw;
    cg::grid_group grid = cg::this_grid();
    unsigned* const gbar = (unsigned*)p.ws; unsigned gtarget = 0;
#define GSYNC() do { asm volatile("s_waitcnt vmcnt(0) lgkmcnt(0)" ::: "memory"); __syncthreads(); gtarget = (unsigned)__builtin_amdgcn_readfirstlane((int)(gtarget + gridDim.x)); \
        if (threadIdx.x == 0) { __builtin_amdgcn_fence(__ATOMIC_RELEASE, "agent"); asm volatile("s_waitcnt vmcnt(0)" ::: "memory"); \
            __hip_atomic_fetch_add(gbar, 1u, __ATOMIC_RELAXED, __HIP_MEMORY_SCOPE_AGENT); \
            while (__hip_atomic_load(gbar, __ATOMIC_RELAXED, __HIP_MEMORY_SCOPE_AGENT) < gtarget) __builtin_amdgcn_s_sleep(2); } \
        __syncthreads(); __builtin_amdgcn_fence(__ATOMIC_ACQUIRE, "agent"); asm volatile("s_waitcnt vmcnt(0)" ::: "memory"); } while (0)
    unsigned xtarget = 0;
#define XSYNC() do { asm volatile("s_waitcnt vmcnt(0) lgkmcnt(0)" ::: "memory"); __syncthreads(); xtarget = (unsigned)__builtin_amdgcn_readfirstlane((int)(xtarget + (unsigned)X.cnt)); \
        if (threadIdx.x == 0) { __hip_atomic_fetch_add(xbar, 1u, __ATOMIC_RELAXED, __HIP_MEMORY_SCOPE_AGENT); \
            while (__hip_atomic_load(xbar, __ATOMIC_RELAXED, __HIP_MEMORY_SCOPE_AGENT) < xtarget) __builtin_amdgcn_s_sleep(1); } \
        __syncthreads(); __builtin_amdgcn_fence(__ATOMIC_ACQUIRE, "agent"); asm volatile("s_waitcnt vmcnt(0)" ::: "memory"); } while (0)
    grid.sync();
    const int G = gridDim.x, bid = blockIdx.x, tid = threadIdx.x;
    typedef const Params __attribute__((address_space(4)))* KArg;
    KArg kp = (KArg)__builtin_amdgcn_kernarg_segment_ptr();

    pg8::XInfo X;
    { LAS unsigned* sh = (LAS unsigned*)(lds + 131072);
      if (tid == 0) { const unsigned xc = (unsigned)__builtin_amdgcn_s_getreg((3 << 11) | 20) & 0xFu;
          sh[0] = xc; sh[1] = __hip_atomic_fetch_add(gbar + 64 + 64 * xc, 1u, __ATOMIC_RELAXED, __HIP_MEMORY_SCOPE_AGENT); }
      __syncthreads();
      const unsigned xcc = sh[0]; X.r = (int)sh[1];
      p0_prologue(p, lds);
      GSYNC();
      int nx = 0, xi = 0, cnt = 0;
      for (unsigned j = 0; j < 16; ++j) { const unsigned cj = __hip_atomic_load(gbar + 64 + 64 * j, __ATOMIC_RELAXED, __HIP_MEMORY_SCOPE_AGENT); if (cj) { if (j == xcc) { xi = nx; cnt = (int)cj; } ++nx; } }
      X.xi = __builtin_amdgcn_readfirstlane(xi); X.nx = __builtin_amdgcn_readfirstlane(nx); X.cnt = __builtin_amdgcn_readfirstlane(cnt); X.r = __builtin_amdgcn_readfirstlane(X.r);
      X.nbx = (NB - X.xi + X.nx - 1) / X.nx; }
    unsigned* const xbar = gbar + 2048 + 64 * __builtin_amdgcn_readfirstlane((int)((LAS unsigned*)(lds + 131072))[0]);
#pragma unroll 1
    for (int l = 0; l < NL; ++l) {
        KArg q = kp; asm volatile("" : "+s"(q));
        unsigned char* ws = q->ws; float* xout = q->out;
        float* MOD = (float*)(ws + WS_MOD);
        bf16_t* WSP = (bf16_t*)(ws + WS_WSP); bf16_t* WPT = (bf16_t*)(ws + WS_WPT);
        bf16_t* WIN = (bf16_t*)(ws + WS_WIN); bf16_t* WMG = (bf16_t*)(ws + WS_WMG); bf16_t* WOUT = (bf16_t*)(ws + WS_WOUT);
        bf16_t* WFI = (bf16_t*)(ws + WS_WFI); bf16_t* WFO = (bf16_t*)(ws + WS_WFO);
        bf16_t* ACT = (bf16_t*)(ws + WS_ACT); bf16_t* MID = (bf16_t*)(ws + WS_MID); bf16_t* MRG = (bf16_t*)(ws + WS_MRG); bf16_t* FB = (bf16_t*)(ws + WS_F);
        const float* xs = (l == 0) ? q->in[I_X] : xout;
        const float* modl = MOD + (size_t)l * NB * NMOD;
        norm_phase(X, xs, q->in[I_G1] + l * DM, modl, 0, DM, ACT);
        XSYNC();
        { pg8::Gemm g{ACT, WIN + (size_t)l * 3072 * DM, ACT_LD, DM}; pg8::StaticOrder S; S.init(X, 3072, 16); pg8::EpiIn E{MID};
          pg8::gemm_phase<pg8::EpiIn, pg8::StaticOrder>(lds, g, S, E); }
        XSYNC();
        for (int u = X.r; u < X.nbx * 16; u += X.cnt)
            gmlp_unit(lds, X.xi + (u >> 4) * X.nx, u & 15, MID, WSP + (size_t)l * 4 * 128 * 128, q->in[I_LNG] + l * BW, q->in[I_LNB] + l * BW, q->in[I_BSP] + l * 4 * 128, ACT);
        for (int u = X.r; u < X.nbx * 16; u += X.cnt)
            pool_unit(lds, X.xi + (u >> 4) * X.nx, u & 15, MID, WPT + (size_t)l * 4 * 128 * 128, q->in[I_PS] + l * BW, ACT);
        { const int t2 = opaque_tid();
          for (int wu = X.r; wu < X.nbx * 64; wu += X.cnt) { const int bhl = wu >> 3;
              attn_wg(lds, X.xi + (bhl >> 3) * X.nx, bhl & 7, (wu & 7) * 8, MID, ACT, t2); } }
        XSYNC();
        { const int sb = X.xi + (X.r >> 5) * X.nx;
          unsigned char* scr = ws + WS_SCR + (size_t)sb * SEQ * MID_LD * 2 + (size_t)(X.r & 31) * SCR_PER_WG;
          pg8::Gemm g{ACT, WMG + (size_t)l * DM * WMG_LD, ACT_LD, WMG_LD}; pg8::MergeOrder S; S.init(X);
          pg8::EpiMerge E{(u32x4*)scr, (f32x4*)(scr + 131072), MRG};
          pg8::gemm_phase<pg8::EpiMerge, pg8::MergeOrder>(lds, g, S, E); }
        XSYNC();
        { pg8::Gemm g{MRG, WOUT + (size_t)l * DM * DM, DM, DM}; pg8::StaticOrder S; S.init(X, DM, 16); pg8::EpiRes E{xs, xout, modl + 2 * DM};
          pg8::gemm_phase<pg8::EpiRes, pg8::StaticOrder>(lds, g, S, E); }
        XSYNC();
        norm_phase(X, xout, q->in[I_G2] + l * DM, modl, 3 * DM, 4 * DM, ACT);
        XSYNC();
        { pg8::Gemm g{ACT, WFI + (size_t)l * 2 * FF * DM, ACT_LD, DM}; pg8::StaticOrder S; S.init(X, 2 * FF, 16); pg8::EpiFfn E{FB};
          pg8::gemm_phase<pg8::EpiFfn, pg8::StaticOrder>(lds, g, S, E); }
        XSYNC();
        { pg8::Gemm g{FB, WFO + (size_t)l * DM * FF, MID_LD, FF}; pg8::StaticOrder S; S.init(X, DM, FF / 64); pg8::EpiRes E{xout, xout, modl + 5 * DM};
          pg8::gemm_phase<pg8::EpiRes, pg8::StaticOrder>(lds, g, S, E); }
        XSYNC();
    }
    final_norm(X, kp->out, kp->in[I_FG]);
}

extern "C" void kernel_launch(void* const* d_in, const int* in_sizes, int n_in, void* d_out, int out_size, void* d_ws, size_t ws_size, hipStream_t stream) {
    static int grid = 0;
    if (grid == 0) {
        if (n_in != 18 || in_sizes[0] != NTOK * DM || out_size != NTOK * DM || ws_size < WS_END) {
            fprintf(stderr, "kernel_launch: unexpected shapes (n_in %d, in0 %d, out %d, ws %zu, need %zu)\n", n_in, n_in > 0 ? in_sizes[0] : -1, out_size, ws_size, (size_t)WS_END); grid = -1; return; }
        int dev = 0, cus = 0, per_cu = 0;
        if (hipGetDevice(&dev) != hipSuccess || hipDeviceGetAttribute(&cus, hipDeviceAttributeMultiprocessorCount, dev) != hipSuccess) { grid = -1; return; }
        if (hipFuncSetAttribute((const void*)fwd_megakernel, hipFuncAttributeMaxDynamicSharedMemorySize, LDS_BYTES) != hipSuccess) { fprintf(stderr, "kernel_launch: hipFuncSetAttribute failed\n"); grid = -1; return; }
        if (hipOccupancyMaxActiveBlocksPerMultiprocessor(&per_cu, (const void*)fwd_megakernel, 512, LDS_BYTES) != hipSuccess || per_cu < 1) { fprintf(stderr, "kernel_launch: occupancy query gave %d\n", per_cu); per_cu = 1; }
        (void)hipGetLastError();
        grid = cus < MAX_GRID ? cus : MAX_GRID;
    }
    if (grid < 0) return;
    if (hipMemsetAsync(d_ws, 0, 16384, stream) != hipSuccess) { fprintf(stderr, "kernel_launch: memset failed\n"); return; }
    Params p{};
    for (int i = 0; i < 18; ++i) p.in[i] = (const float*)d_in[i];
    p.out = (float*)d_out; p.ws = (unsigned char*)d_ws;
    p.ph_lo = 0; p.ph_hi = 46; p.coop = 1;
    void* args[] = {&p};
    hipError_t e = hipLaunchCooperativeKernel((const void*)fwd_megakernel, dim3(grid), dim3(512), args, LDS_BYTES, stream);
    if (e != hipSuccess) fprintf(stderr, "cooperative launch failed: %s (grid %d)\n", hipGetErrorString(e), grid);
}
```

```cpp
#include <hip/hip_runtime.h>
#include <hip/hip_cooperative_groups.h>
#include <cstdio>
#include <cstdint>
namespace cg = cooperative_groups;

#define LAS __attribute__((address_space(3)))
typedef unsigned short bf16_t;
typedef short bf16x8 __attribute__((ext_vector_type(8)));
typedef short s16x4 __attribute__((ext_vector_type(4)));
typedef float f32x4 __attribute__((ext_vector_type(4)));
typedef float f32x2 __attribute__((ext_vector_type(2)));
typedef float f32x16 __attribute__((ext_vector_type(16)));
typedef unsigned u32x4 __attribute__((ext_vector_type(4)));
typedef unsigned u32x2 __attribute__((ext_vector_type(2)));

constexpr int NB = 32, SEQ = 2048, DM = 1024, NTOK = NB * SEQ, NL = 4, BW = 512, FF = 2816;
constexpr int ACT_LD = 2560;
constexpr int MID_LD = 3072;
constexpr int WMG_LD = 4608;
constexpr int NMOD = 6 * DM;
constexpr float EPS = 1e-6f;
constexpr float LOG2E = 1.4426950408889634f;

constexpr size_t MiB = (size_t)1 << 20;
constexpr size_t WS_MOD = 1 * MiB;
constexpr size_t WS_WSP = 4 * MiB;
constexpr size_t WS_WPT = 5 * MiB;
constexpr size_t WS_WIN = 6 * MiB;
constexpr size_t WS_WMG = 30 * MiB;
constexpr size_t WS_WOUT = 66 * MiB;
constexpr size_t WS_WFI = 74 * MiB;
constexpr size_t WS_WFO = 118 * MiB;
constexpr size_t WS_ACT = 140 * MiB;
constexpr size_t WS_MID = 460 * MiB;
constexpr size_t WS_SCR = 460 * MiB;
constexpr size_t SCR_PER_WG = 384 * 1024;
static_assert((size_t)SEQ * MID_LD * 2 == 32 * SCR_PER_WG, "a batch's MID block holds exactly 32 scratch slots");
constexpr size_t WS_MRG = 844 * MiB;
constexpr size_t WS_F = 460 * MiB;
constexpr size_t WS_END = 972 * MiB;
constexpr int MAX_GRID = 256;

constexpr int LDS_BYTES = 147456;

__device__ __forceinline__ unsigned f2bf(float f) { unsigned u = __builtin_bit_cast(unsigned, f); return (u + 0x7fffu + ((u >> 16) & 1u)) >> 16; }
typedef __bf16 bf16x2_t __attribute__((ext_vector_type(2)));
__device__ __forceinline__ unsigned pk2(float lo, float hi) { const f32x2 v = {lo, hi}; return __builtin_bit_cast(unsigned, __builtin_convertvector(v, bf16x2_t)); }
__device__ __forceinline__ float bflo(unsigned u) { return __builtin_bit_cast(float, u << 16); }
__device__ __forceinline__ float bfhi(unsigned u) { return __builtin_bit_cast(float, u & 0xffff0000u); }
__device__ __forceinline__ float fast_sigmoid(float x) { return __builtin_amdgcn_rcpf(1.0f + __builtin_amdgcn_exp2f(-LOG2E * x)); }
__device__ __forceinline__ float gelu_tanh(float x) {
    const float u = x * (1.0f + 0.044715f * x * x);
    return x * __builtin_amdgcn_rcpf(1.0f + __builtin_amdgcn_exp2f(-2.302208198f * u));
}
__device__ __forceinline__ int opaque_tid() { int t = threadIdx.x; asm volatile("" : "+v"(t)); return t; }
__device__ __forceinline__ float shx(float v, int lane, int o) { return __builtin_bit_cast(float, __builtin_amdgcn_ds_bpermute((lane ^ o) << 2, __builtin_bit_cast(int, v))); }
__device__ __forceinline__ float wave_sum(float v, int lane) {
#pragma unroll
    for (int o = 32; o >= 1; o >>= 1) v += shx(v, lane, o);
    return v;
}

namespace pg8 {
constexpr int BM = 256, BK = 64, HALF = 128, HTB = HALF * BK * 2, STAGE_BYTES = 8 * HTB, NXCD = 8, WGM = 8;
__host__ __device__ __forceinline__ int lds_byte(int r, int c) { const int st = (r >> 4) * 2 + (c >> 5), rr = r & 15, cc = c & 31, ob = rr * 64 + cc * 2; return st * 1024 + (ob ^ (((ob >> 9) & 1) << 5)); }
__host__ __device__ __forceinline__ void stage_rc(int b, int& R, int& C) { const int st = b / 1024, sb = b % 1024, swz = sb ^ (((sb >> 9) & 1) << 5); R = (st >> 1) * 16 + swz / 64; C = (st & 1) * 32 + (swz % 64) / 2; }
__host__ __device__ __forceinline__ int perm32(int rho) { const int n = rho >> 4, i = rho & 15; return 8 * (i >> 2) + 4 * n + (i & 3); }

struct Unit { int pm, pn, ak, bk, nt, kind; };
struct Gemm { const bf16_t* A; const bf16_t* Bt; int lda, ldb; };

__host__ __device__ __forceinline__ void tile_map(int nM, int nN, int L, int& pm, int& pn) {
    const int nwg = nM * nN; int wgid = L;
    { const int q = nwg / NXCD, r = nwg % NXCD, xcd = wgid % NXCD, off = wgid / NXCD; wgid = (xcd < r ? xcd * (q + 1) : r * (q + 1) + (xcd - r) * q) + off; }
    const int nig = WGM * nN, gid = wgid / nig, fm = gid * WGM, gsz = (nM - fm) < WGM ? (nM - fm) : WGM;
    pm = fm + ((wgid % nig) % gsz); pn = (wgid % nig) / gsz;
}
struct XInfo { int xi, nx, r, cnt, nbx; };
struct StaticOrder {
    XInfo X; int nN, nwg, nt, ak, bk;
    __device__ void init(const XInfo& X_, int N, int nt_, int ak_ = 0, int bk_ = 0) { X = X_; nN = N / BM; nwg = 8 * X.nbx * nN; nt = nt_; ak = ak_; bk = bk_; }
    __device__ __forceinline__ bool next(int i, Unit& u) const {
        const int t = i * X.cnt + X.r; if (t >= nwg) return false;
        const int nig = WGM * nN, gid = t / nig, q = t - gid * nig, pml = gid * WGM + (q & 7);
        u.pn = q >> 3; u.pm = (X.xi + (pml >> 3) * X.nx) * 8 + (pml & 7); u.ak = ak; u.bk = bk; u.nt = nt; u.kind = 0; return true;
    }
};
struct MergeOrder {
    XInfo X; int nwg;
    __device__ void init(const XInfo& X_) { X = X_; nwg = 8 * X.nbx * 4; }
    __device__ __forceinline__ bool next(int i, Unit& u) const {
        const int ti = i / 6, st = i - ti * 6, t = ti * X.cnt + X.r; if (t >= nwg) return false;
        const int nig = WGM * 4, gid = t / nig, q = t - gid * nig, pml = gid * WGM + (q & 7), n = st >> 1;
        u.pn = q >> 3; u.pm = (X.xi + (pml >> 3) * X.nx) * 8 + (pml & 7);
        if ((st & 1) == 0) { u.ak = 0; u.bk = n * 1024; u.nt = 16; } else { u.ak = 1024 + n * 512; u.bk = 3072 + n * 512; u.nt = 8; }
        u.kind = st; return true;
    }
};

struct EpiIn {
    static constexpr bool PERM = true;
    bf16_t* O;
    __device__ __forceinline__ void operator()(const f32x4 (&acc)[2][2][4][2], const Unit& u, int wr, int wc, int fr, int fq) const {
        const int row0 = u.pm * BM + wr * 64 + fr, col0 = u.pn * BM + wc * 32 + 8 * fq;
        const int mode = u.pn < 4 ? 1 : (u.pn < 6 ? 2 : 0);
#pragma unroll
        for (int ai = 0; ai < 2; ++ai)
#pragma unroll
            for (int m = 0; m < 4; ++m) { bf16_t* rowp = O + (size_t)(row0 + ai * HALF + m * 16) * MID_LD + col0;
#pragma unroll
                for (int bj = 0; bj < 2; ++bj) { f32x4 v0 = acc[ai][bj][m][0], v1 = acc[ai][bj][m][1];
                    if (mode == 1) {
#pragma unroll
                        for (int e = 0; e < 4; ++e) { v0[e] = gelu_tanh(v0[e]); v1[e] = gelu_tanh(v1[e]); }
                    } else if (mode == 2) { v0 = v0 * 0.125f; v1 = v1 * 0.125f; }
                    u32x4 w; w.x = pk2(v0[0], v0[1]); w.y = pk2(v0[2], v0[3]); w.z = pk2(v1[0], v1[1]); w.w = pk2(v1[2], v1[3]);
                    *(u32x4*)(rowp + bj * HALF) = w; } }
    }
};
struct EpiRes {
    static constexpr bool PERM = false;
    const float* xs; float* out; const float* gate;
    __device__ __forceinline__ void operator()(const f32x4 (&acc)[2][2][4][2], const Unit& u, int wr, int wc, int fr, int fq) const {
        const int row0 = u.pm * BM + wr * 64 + fr, col0 = u.pn * BM + wc * 32 + 4 * fq;
        const float* gp = gate + (size_t)(u.pm >> 3) * NMOD + col0;
        f32x4 gv[2][2];
#pragma unroll
        for (int bj = 0; bj < 2; ++bj)
#pragma unroll
            for (int n = 0; n < 2; ++n) gv[bj][n] = *(const f32x4*)(gp + bj * HALF + n * 16);
#pragma unroll
        for (int ai = 0; ai < 2; ++ai)
#pragma unroll
            for (int m = 0; m < 4; ++m) { const size_t off = (size_t)(row0 + ai * HALF + m * 16) * DM + col0;
#pragma unroll
                for (int bj = 0; bj < 2; ++bj)
#pragma unroll
                    for (int n = 0; n < 2; ++n) { const f32x4 xv = *(const f32x4*)(xs + off + bj * HALF + n * 16);
                        *(f32x4*)(out + off + bj * HALF + n * 16) = xv + gv[bj][n] * acc[ai][bj][m][n]; }
                if (m & 1) asm volatile("" ::: "memory"); }
    }
};
struct EpiFfn {
    static constexpr bool PERM = true;
    bf16_t* O;
    __device__ __forceinline__ void operator()(const f32x4 (&acc)[2][2][4][2], const Unit& u, int wr, int wc, int fr, int fq) const {
        const int row0 = u.pm * BM + wr * 64 + fr, col0 = u.pn * HALF + wc * 32 + 8 * fq;
#pragma unroll
        for (int ai = 0; ai < 2; ++ai)
#pragma unroll
            for (int m = 0; m < 4; ++m) { bf16_t* rowp = O + (size_t)(row0 + ai * HALF + m * 16) * MID_LD + col0;
                f32x4 r[2];
#pragma unroll
                for (int n = 0; n < 2; ++n) { const f32x4 g = acc[ai][0][m][n], up = acc[ai][1][m][n];
#pragma unroll
                    for (int e = 0; e < 4; ++e) r[n][e] = g[e] * fast_sigmoid(g[e]) * up[e]; }
                u32x4 w; w.x = pk2(r[0][0], r[0][1]); w.y = pk2(r[0][2], r[0][3]); w.z = pk2(r[1][0], r[1][1]); w.w = pk2(r[1][2], r[1][3]);
                *(u32x4*)rowp = w; }
    }
};
struct EpiMerge {
    static constexpr bool PERM = true;
    u32x4* gs; u32x4* ms; bf16_t* O;
    __device__ __forceinline__ void operator()(const f32x4 (&acc)[2][2][4][2], const Unit& u, int wr, int wc, int fr, int fq) const {
        const int tid = opaque_tid(), kind = u.kind;
        if ((kind & 1) == 0) {
#pragma unroll
            for (int ai = 0; ai < 2; ++ai)
#pragma unroll
                for (int bj = 0; bj < 2; ++bj)
#pragma unroll
                    for (int m = 0; m < 4; ++m) { const int j = (ai * 2 + bj) * 4 + m; f32x4 v0 = acc[ai][bj][m][0], v1 = acc[ai][bj][m][1];
#pragma unroll
                        for (int e = 0; e < 4; ++e) { v0[e] = fast_sigmoid(v0[e]); v1[e] = fast_sigmoid(v1[e]); }
                        u32x4 w; w.x = pk2(v0[0], v0[1]); w.y = pk2(v0[2], v0[3]); w.z = pk2(v1[0], v1[1]); w.w = pk2(v1[2], v1[3]);
                        gs[j * 512 + tid] = w; }
        } else {
            const int row0 = u.pm * BM + wr * 64 + fr, col0 = u.pn * BM + wc * 32 + 8 * fq;
#pragma unroll
            for (int ab = 0; ab < 4; ++ab) { const int ai = ab >> 1, bj = ab & 1;
                u32x4 gw[4], mw[4];
#pragma unroll
                for (int m = 0; m < 4; ++m) { const int j = ab * 4 + m; gw[m] = gs[j * 512 + tid]; mw[m] = (u32x4){0u, 0u, 0u, 0u}; if (kind != 1) mw[m] = ms[j * 512 + tid]; }
#pragma unroll
                for (int m = 0; m < 4; ++m) { const int j = ab * 4 + m;
                    f32x4 p0 = acc[ai][bj][m][0], p1 = acc[ai][bj][m][1];
                    p0[0] = p0[0] * bflo(gw[m].x) + bflo(mw[m].x); p0[1] = p0[1] * bfhi(gw[m].x) + bfhi(mw[m].x); p0[2] = p0[2] * bflo(gw[m].y) + bflo(mw[m].y); p0[3] = p0[3] * bfhi(gw[m].y) + bfhi(mw[m].y);
                    p1[0] = p1[0] * bflo(gw[m].z) + bflo(mw[m].z); p1[1] = p1[1] * bfhi(gw[m].z) + bfhi(mw[m].z); p1[2] = p1[2] * bflo(gw[m].w) + bflo(mw[m].w); p1[3] = p1[3] * bfhi(gw[m].w) + bfhi(mw[m].w);
                    u32x4 w; w.x = pk2(p0[0], p0[1]); w.y = pk2(p0[2], p0[3]); w.z = pk2(p1[0], p1[1]); w.w = pk2(p1[2], p1[3]);
                    if (kind != 5) ms[j * 512 + tid] = w;
                    else *(u32x4*)(O + (size_t)(row0 + ai * HALF + m * 16) * DM + col0 + bj * HALF) = w; }
                asm volatile("" ::: "memory"); }
        }
    }
};

template <class Epi, class Sched, bool ALIGN_EPI = true>
__device__ __forceinline__ void gemm_phase(LAS unsigned char* lds, const Gemm g, const Sched& S, const Epi& E) {
    const int tid = opaque_tid(), wid = __builtin_amdgcn_readfirstlane(tid >> 6), lane = tid & 63, wr = wid >> 2, wc = wid & 3, fr = lane & 15, fq = lane >> 4;
    unsigned voffA[2], voffB[2];
#pragma unroll
    for (int i = 0; i < 2; ++i) { int R, C; stage_rc(tid * 16 + i * 8192, R, C); const int Rb = Epi::PERM ? ((R & ~31) + perm32(R & 31)) : R;
        voffA[i] = (unsigned)(R * g.lda + C) * 2u; voffB[i] = (unsigned)(Rb * g.ldb + C) * 2u; }
    const size_t kstep = (size_t)(BK * 2);
    const size_t hstepA = (size_t)HALF * g.lda * 2, hstepB = (size_t)HALF * g.ldb * 2;
    const size_t tstepA = 2 * hstepA, tstepB = 2 * hstepB;
    const unsigned ldsw = (unsigned)wid * 1024u;
    const int aoff = lds_byte(wr * 64 + fr, fq * 8), boff = lds_byte(wc * 32 + fr, fq * 8);
#define PG8_SA(b, h) (((b) * 2 + (h)) * HTB)
#define PG8_SB(b, h) ((4 + (b) * 2 + (h)) * HTB)
#define PG8_STAGE(bufoff, gbase, voff) do { _Pragma("unroll") for (int _i = 0; _i < 2; ++_i) \
        __builtin_amdgcn_global_load_lds((const unsigned*)((const char*)(gbase) + (voff)[_i]), (LAS unsigned*)(lds + (bufoff) + ldsw + _i * 8192), 16, 0, 0); } while (0)
#define PG8_LDA(dst, b, h) do { _Pragma("unroll") for (int m = 0; m < 4; ++m) _Pragma("unroll") for (int k = 0; k < 2; ++k) dst[m][k] = *(const LAS bf16x8*)(lds + PG8_SA(b, h) + aoff + m * 2048 + k * 1024); } while (0)
#define PG8_LDB(dst, b, h) do { _Pragma("unroll") for (int n = 0; n < 2; ++n) _Pragma("unroll") for (int k = 0; k < 2; ++k) dst[n][k] = *(const LAS bf16x8*)(lds + PG8_SB(b, h) + boff + n * 2048 + k * 1024); } while (0)
#define PG8_MMA(ai, bj, At, Bt) do { __builtin_amdgcn_s_setprio(1); _Pragma("unroll") for (int m = 0; m < 4; ++m) _Pragma("unroll") for (int n = 0; n < 2; ++n) _Pragma("unroll") for (int k = 0; k < 2; ++k) \
        acc[ai][bj][m][n] = __builtin_amdgcn_mfma_f32_16x16x32_bf16(Bt[n][k], At[m][k], acc[ai][bj][m][n], 0, 0, 0); __builtin_amdgcn_s_setprio(0); } while (0)
#define PG8_WAIT_V(n) asm volatile("s_waitcnt vmcnt(" #n ")" ::: "memory")
#define PG8_WAIT_L(n) asm volatile("s_waitcnt lgkmcnt(" #n ")" ::: "memory")
#define PG8_BAR __builtin_amdgcn_s_barrier()
#define PG8_SCHED __builtin_amdgcn_sched_barrier(0)
    Unit cur, nxt; int ui = 0;
    if (!S.next(0, cur)) return;
    f32x4 acc[2][2][4][2];
#pragma unroll
    for (int a = 0; a < 2; ++a)
#pragma unroll
        for (int b = 0; b < 2; ++b)
#pragma unroll
            for (int m = 0; m < 4; ++m)
#pragma unroll
                for (int n = 0; n < 2; ++n) acc[a][b][m][n] = (f32x4){0.f, 0.f, 0.f, 0.f};
    bf16x8 At[4][2], B0[2][2], B1[2][2];
    const char* cA = (const char*)g.A + (size_t)cur.pm * tstepA + (size_t)cur.ak * 2; const char* cB = (const char*)g.Bt + (size_t)cur.pn * tstepB + (size_t)cur.bk * 2;
    PG8_STAGE(PG8_SB(0, 0), cB, voffB); PG8_STAGE(PG8_SB(0, 1), cB + hstepB, voffB); PG8_STAGE(PG8_SA(0, 0), cA, voffA); PG8_STAGE(PG8_SA(0, 1), cA + hstepA, voffA);
    if (wr == 1) PG8_BAR;
    PG8_WAIT_V(2); PG8_BAR;
    PG8_STAGE(PG8_SB(1, 0), cB + kstep, voffB); PG8_STAGE(PG8_SA(1, 0), cA + kstep, voffA); PG8_STAGE(PG8_SB(1, 1), cB + hstepB + kstep, voffB);
    PG8_WAIT_V(6); PG8_BAR;
    for (;;) {
        const bool has_next = S.next(ui + 1, nxt);
        const char* nA = has_next ? (const char*)g.A + (size_t)nxt.pm * tstepA + (size_t)nxt.ak * 2 : cA;
        const char* nB = has_next ? (const char*)g.Bt + (size_t)nxt.pn * tstepB + (size_t)nxt.bk * 2 : cB;
        const int nt = cur.nt;
        for (int t = 0; t < nt; t += 2) {
            const bool last = (t == nt - 2);
            const char* a1 = cA + (size_t)(t + 1) * kstep;
            const char* a2 = last ? nA : cA + (size_t)(t + 2) * kstep; const char* b2 = last ? nB : cB + (size_t)(t + 2) * kstep;
            const char* a3 = a2 + kstep; const char* b3 = b2 + kstep;
            PG8_LDB(B0, 0, 0); PG8_LDB(B1, 0, 1); PG8_SCHED; PG8_LDA(At, 0, 0); PG8_STAGE(PG8_SA(1, 1), a1 + hstepA, voffA);
            PG8_WAIT_V(8); PG8_WAIT_L(0); PG8_BAR; PG8_MMA(0, 0, At, B0); PG8_MMA(0, 1, At, B1); PG8_BAR; PG8_SCHED;
            PG8_LDA(At, 0, 1); PG8_STAGE(PG8_SB(0, 0), b2, voffB); PG8_STAGE(PG8_SB(0, 1), b2 + hstepB, voffB); PG8_STAGE(PG8_SA(0, 0), a2, voffA);
            PG8_WAIT_V(8); PG8_WAIT_L(0); PG8_BAR; PG8_MMA(1, 0, At, B0); PG8_MMA(1, 1, At, B1); PG8_BAR; PG8_SCHED;
            PG8_LDB(B0, 1, 0); PG8_LDB(B1, 1, 1); PG8_SCHED; PG8_LDA(At, 1, 0); PG8_STAGE(PG8_SA(0, 1), a2 + hstepA, voffA);
            PG8_WAIT_V(8); PG8_WAIT_L(0); PG8_BAR; PG8_MMA(0, 0, At, B0); PG8_MMA(0, 1, At, B1); PG8_BAR; PG8_SCHED;
            PG8_LDA(At, 1, 1); PG8_STAGE(PG8_SB(1, 0), b3, voffB); PG8_STAGE(PG8_SB(1, 1), b3 + hstepB, voffB); PG8_STAGE(PG8_SA(1, 0), a3, voffA);
            PG8_WAIT_V(8); PG8_WAIT_L(0); PG8_BAR; PG8_MMA(1, 0, At, B0); PG8_MMA(1, 1, At, B1); PG8_BAR; PG8_SCHED;
        }
        if constexpr (ALIGN_EPI) { if (wr == 0) PG8_BAR; }
        E(acc, cur, wr, wc, fr, fq);
        if (!has_next) break;
#pragma unroll
        for (int a = 0; a < 2; ++a)
#pragma unroll
            for (int b = 0; b < 2; ++b)
#pragma unroll
                for (int m = 0; m < 4; ++m)
#pragma unroll
                    for (int n = 0; n < 2; ++n) acc[a][b][m][n] = (f32x4){0.f, 0.f, 0.f, 0.f};
        cur = nxt; cA = nA; cB = nB; ++ui;
        if constexpr (ALIGN_EPI) { if (wr == 1) PG8_BAR; }
    }
    PG8_WAIT_V(0);
    if constexpr (!ALIGN_EPI) { if (wr == 0) PG8_BAR; }
    PG8_BAR;
#undef PG8_SA
#undef PG8_SB
#undef PG8_STAGE
#undef PG8_LDA
#undef PG8_LDB
#undef PG8_MMA
#undef PG8_WAIT_V
#undef PG8_WAIT_L
#undef PG8_BAR
#undef PG8_SCHED
}
}

struct Params { const float* in[18]; float* out; unsigned char* ws; int ph_lo, ph_hi, coop, pad; };
enum { I_X = 0, I_C, I_G1, I_G2, I_WADA, I_BADA, I_WIN, I_LNG, I_LNB, I_WSP, I_BSP, I_PW, I_PS, I_WBR, I_WOUT, I_WFI, I_WFO, I_FG };

#define MFMA32(a, b, c) __builtin_amdgcn_mfma_f32_32x32x16_bf16(a, b, c, 0, 0, 0)
typedef short v4i16_t __attribute__((ext_vector_type(4)));
__device__ __forceinline__ s16x4 tr_read(LAS const unsigned char* p) { return __builtin_bit_cast(s16x4, __builtin_amdgcn_ds_read_tr16_b64_v4i16((LAS v4i16_t*)p)); }
__device__ __forceinline__ bf16x8 cat8(s16x4 a, s16x4 b) { bf16x8 r; r[0] = a[0]; r[1] = a[1]; r[2] = a[2]; r[3] = a[3]; r[4] = b[0]; r[5] = b[1]; r[6] = b[2]; r[7] = b[3]; return r; }

__device__ __forceinline__ void transpose_tile(LAS float* tl, const float* src, int ld, bf16_t* dst, int ldd) {
    const int tid = opaque_tid();
    { const int r = tid >> 4, c4 = (tid & 15) * 4;
#pragma unroll
      for (int h = 0; h < 2; ++h) { const int k = r + 32 * h; const f32x4 v = *(const f32x4*)(src + (size_t)k * ld + c4);
          tl[k * 65 + c4] = v[0]; tl[k * 65 + c4 + 1] = v[1]; tl[k * 65 + c4 + 2] = v[2]; tl[k * 65 + c4 + 3] = v[3]; } }
    __syncthreads();
    { const int n = tid >> 3, k8 = (tid & 7) * 8; float v[8];
#pragma unroll
      for (int j = 0; j < 8; ++j) v[j] = tl[(k8 + j) * 65 + n];
      u32x4 w; w.x = pk2(v[0], v[1]); w.y = pk2(v[2], v[3]); w.z = pk2(v[4], v[5]); w.w = pk2(v[6], v[7]);
      *(u32x4*)(dst + (size_t)n * ldd + k8) = w; }
    __syncthreads();
}

__device__ __forceinline__ void p0_prologue(const Params& p, LAS unsigned char* lds) {
    const int tid = opaque_tid(), G = gridDim.x, bid = blockIdx.x;
    unsigned char* ws = p.ws;
    bf16_t* WIN = (bf16_t*)(ws + WS_WIN); bf16_t* WMG = (bf16_t*)(ws + WS_WMG); bf16_t* WOUT = (bf16_t*)(ws + WS_WOUT);
    bf16_t* WFI = (bf16_t*)(ws + WS_WFI); bf16_t* WFO = (bf16_t*)(ws + WS_WFO); bf16_t* WPT = (bf16_t*)(ws + WS_WPT); bf16_t* WSP = (bf16_t*)(ws + WS_WSP);
    LAS float* tl = (LAS float*)lds;
    constexpr int TPL = 4304;
    for (int J = bid; J < NL * TPL; J += G) {
        const int l = J / TPL; int j = J - l * TPL;
        const float* src; int ld; bf16_t* dst; int ldd;
        if (j < 768) { const int kt = j / 48, ntile = j % 48;
            src = p.in[I_WIN] + ((size_t)l * DM + kt * 64) * 6144 + ntile * 64; ld = 6144; dst = WIN + ((size_t)l * 3072 + ntile * 64) * DM + kt * 64; ldd = DM; }
        else if (j < 1536) { j -= 768; const int kt = j / 48, ntile = j % 48, br = ntile >> 4, n0 = (ntile & 15) * 64;
            src = p.in[I_WIN] + ((size_t)l * DM + kt * 64) * 6144 + 3072 + ntile * 64; ld = 6144; dst = WMG + ((size_t)l * DM + n0) * WMG_LD + br * 1024 + kt * 64; ldd = WMG_LD; }
        else if (j < 1920) { j -= 1536; const int br = j >> 7, r = j & 127, kt = r >> 4, ntile = r & 15;
            src = p.in[I_WBR] + ((size_t)(l * 3 + br) * BW + kt * 64) * DM + ntile * 64; ld = DM; dst = WMG + ((size_t)l * DM + ntile * 64) * WMG_LD + 3072 + br * 512 + kt * 64; ldd = WMG_LD; }
        else if (j < 2176) { j -= 1920; const int kt = j >> 4, ntile = j & 15;
            src = p.in[I_WOUT] + ((size_t)l * DM + kt * 64) * DM + ntile * 64; ld = DM; dst = WOUT + ((size_t)l * DM + ntile * 64) * DM + kt * 64; ldd = DM; }
        else if (j < 3584) { j -= 2176; const int kt = j / 88, ntile = j % 88, c0 = ntile * 64; const bool up = c0 >= FF; const int f0 = up ? c0 - FF : c0;
            const int np = 256 * (f0 >> 7) + (f0 & 127) + (up ? 128 : 0);
            src = p.in[I_WFI] + ((size_t)l * DM + kt * 64) * (2 * FF) + c0; ld = 2 * FF; dst = WFI + ((size_t)l * (2 * FF) + np) * DM + kt * 64; ldd = DM; }
        else if (j < 4288) { j -= 3584; const int kt = j >> 4, ntile = j & 15;
            src = p.in[I_WFO] + ((size_t)l * FF + kt * 64) * DM + ntile * 64; ld = DM; dst = WFO + ((size_t)l * DM + ntile * 64) * FF + kt * 64; ldd = FF; }
        else { j -= 4288; const int gg = j >> 2, r = j & 3, kt = r >> 1, ntile = r & 1;
            src = p.in[I_PW] + ((size_t)(l * 4 + gg) * 128 + kt * 64) * 128 + ntile * 64; ld = 128; dst = WPT + ((size_t)(l * 4 + gg) * 128 + ntile * 64) * 128 + kt * 64; ldd = 128; }
        transpose_tile(tl, src, ld, dst, ldd);
    }
    for (int idx = bid * 512 + tid; idx < NL * 4 * 128 * 128; idx += G * 512) { const int t = (idx >> 7) & 127, s = idx & 127; WSP[idx] = (s <= t) ? (bf16_t)f2bf(p.in[I_WSP][idx]) : (bf16_t)0; }
    LAS float* ca = (LAS float*)lds;
    float* MOD = (float*)(ws + WS_MOD);
    for (int cgp = bid; cgp < (NL * NMOD) / 96; cgp += G) {
        __syncthreads();
        for (int i = tid; i < NB * DM; i += 512) { const int b = i >> 10, k = i & 1023; const float cv = p.in[I_C][i]; ca[k * 32 + b] = cv * fast_sigmoid(cv); }
        __syncthreads();
        const int cj = tid & 31, ks = tid >> 5;
        float acc[3][32];
#pragma unroll
        for (int q = 0; q < 3; ++q)
#pragma unroll
            for (int b = 0; b < 32; ++b) acc[q][b] = 0.f;
        const int colg = cgp * 96;
        const int l = colg / NMOD, cl = colg - l * NMOD;
        const float* wa = p.in[I_WADA] + (size_t)l * DM * NMOD + cl + cj;
        for (int k = ks * 64; k < ks * 64 + 64; ++k) {
            float w[3];
#pragma unroll
            for (int q = 0; q < 3; ++q) w[q] = wa[(size_t)k * NMOD + q * 32];
            f32x4 cv[8];
#pragma unroll
            for (int i = 0; i < 8; ++i) cv[i] = *(const LAS f32x4*)(ca + k * 32 + i * 4);
#pragma unroll
            for (int q = 0; q < 3; ++q)
#pragma unroll
                for (int b = 0; b < 32; ++b) acc[q][b] += cv[b >> 2][b & 3] * w[q];
        }
        LAS float* red = (LAS float*)lds;
#pragma unroll
        for (int q = 0; q < 3; ++q) {
            __syncthreads();
#pragma unroll
            for (int b = 0; b < 32; ++b) red[(ks * 32 + b) * 32 + cj] = acc[q][b];
            __syncthreads();
            for (int o = tid; o < 1024; o += 512) { const int b = o >> 5, c = o & 31; float s = 0.f;
#pragma unroll
                for (int k2 = 0; k2 < 16; ++k2) s += red[(k2 * 32 + b) * 32 + c];
                const int col = cl + q * 32 + c;
                MOD[((size_t)l * NB + b) * NMOD + col] = s + p.in[I_BADA][(size_t)l * NMOD + col]; }
        }
    }
    __syncthreads();
}

__device__ __forceinline__ void norm_phase(const pg8::XInfo& X, const float* xs, const float* g, const float* modl, int shoff, int scoff, bf16_t* act) {
    const int tid_ = opaque_tid(), lane = tid_ & 63, wid = tid_ >> 6;
    for (int blk = X.r * 8 + wid; blk < X.nbx * 64; blk += X.cnt * 8) {
        const int b = X.xi + (blk >> 6) * X.nx, row0 = b * SEQ + (blk & 63) * 32;
        f32x4 ga[4], sh[4];
#pragma unroll
        for (int j = 0; j < 4; ++j) { const int col = j * 256 + lane * 4; const f32x4 gv = *(const f32x4*)(g + col), sc = *(const f32x4*)(modl + (size_t)b * NMOD + scoff + col);
            ga[j] = gv * (1.0f + sc); sh[j] = *(const f32x4*)(modl + (size_t)b * NMOD + shoff + col); }
#pragma unroll 2
        for (int r = 0; r < 32; ++r) {
            const float* xr = xs + (size_t)(row0 + r) * DM + lane * 4;
            f32x4 x[4]; float ss = 0.f;
#pragma unroll
            for (int j = 0; j < 4; ++j) { x[j] = *(const f32x4*)(xr + j * 256); ss += x[j][0] * x[j][0] + x[j][1] * x[j][1] + x[j][2] * x[j][2] + x[j][3] * x[j][3]; }
            ss = wave_sum(ss, lane);
            const float rstd = 1.0f / sqrtf(ss * (1.0f / DM) + EPS);
            bf16_t* orow = act + (size_t)(row0 + r) * ACT_LD + lane * 4;
#pragma unroll
            for (int j = 0; j < 4; ++j) { const f32x4 y = x[j] * rstd * ga[j] + sh[j]; u32x2 w; w.x = pk2(y[0], y[1]); w.y = pk2(y[2], y[3]); *(u32x2*)(orow + j * 256) = w; }
        }
    }
}
__device__ __forceinline__ void final_norm(const pg8::XInfo& X, float* x, const float* g) {
    const int tid_ = opaque_tid(), lane = tid_ & 63, wid = tid_ >> 6;
    f32x4 gv[4];
#pragma unroll
    for (int j = 0; j < 4; ++j) gv[j] = *(const f32x4*)(g + j * 256 + lane * 4);
    for (int rl = X.r * 8 + wid; rl < X.nbx * SEQ; rl += X.cnt * 8) {
        const int row = (X.xi + (rl >> 11) * X.nx) * SEQ + (rl & 2047);
        float* xr = x + (size_t)row * DM + lane * 4;
        f32x4 v[4]; float ss = 0.f;
#pragma unroll
        for (int j = 0; j < 4; ++j) { v[j] = *(const f32x4*)(xr + j * 256); ss += v[j][0] * v[j][0] + v[j][1] * v[j][1] + v[j][2] * v[j][2] + v[j][3] * v[j][3]; }
        ss = wave_sum(ss, lane);
        const float rstd = 1.0f / sqrtf(ss * (1.0f / DM) + EPS);
#pragma unroll
        for (int j = 0; j < 4; ++j) *(f32x4*)(xr + j * 256) = v[j] * rstd * gv[j];
    }
}

__device__ __forceinline__ void gmlp_unit(LAS unsigned char* lds, int b, int ch, const bf16_t* mid, const bf16_t* wsp, const float* lng, const float* lnb, const float* bsp, bf16_t* act) {
    const int tid = opaque_tid(), lane = tid & 63, wid = tid >> 6;
    const int row0 = b * SEQ + ch * 128;
    {
        const int s = tid >> 2, q = tid & 3;
        const bf16_t* vp = mid + (size_t)(row0 + s) * MID_LD + 512 + q * 8;
        float sum = 0.f, sq = 0.f;
#pragma unroll 4
        for (int i = 0; i < 16; ++i) { const u32x4 v = *(const u32x4*)(vp + i * 32);
            const float a0 = bflo(v.x), a1 = bfhi(v.x), a2 = bflo(v.y), a3 = bfhi(v.y), a4 = bflo(v.z), a5 = bfhi(v.z), a6 = bflo(v.w), a7 = bfhi(v.w);
            sum += ((a0 + a1) + (a2 + a3)) + ((a4 + a5) + (a6 + a7));
            sq += ((a0 * a0 + a1 * a1) + (a2 * a2 + a3 * a3)) + ((a4 * a4 + a5 * a5) + (a6 * a6 + a7 * a7)); }
        sum += shx(sum, lane, 1); sum += shx(sum, lane, 2);
        sq += shx(sq, lane, 1); sq += shx(sq, lane, 2);
        const float mean = sum * (1.0f / BW);
        const float var = fmaxf(sq * (1.0f / BW) - mean * mean, 0.f);
        const float rstd = 1.0f / sqrtf(var + EPS);
#pragma unroll 2
        for (int i = 0; i < 16; ++i) {
            const int c = (4 * i + q) * 8;
            const u32x4 v = *(const u32x4*)(vp + i * 32);
            const f32x4 g0 = *(const f32x4*)(lng + c), g1 = *(const f32x4*)(lng + c + 4), b0 = *(const f32x4*)(lnb + c), b1 = *(const f32x4*)(lnb + c + 4);
            u32x4 w;
            w.x = pk2((bflo(v.x) - mean) * rstd * g0[0] + b0[0], (bfhi(v.x) - mean) * rstd * g0[1] + b0[1]);
            w.y = pk2((bflo(v.y) - mean) * rstd * g0[2] + b0[2], (bfhi(v.y) - mean) * rstd * g0[3] + b0[3]);
            w.z = pk2((bflo(v.z) - mean) * rstd * g1[0] + b1[0], (bfhi(v.z) - mean) * rstd * g1[1] + b1[1]);
            w.w = pk2((bflo(v.w) - mean) * rstd * g1[2] + b1[2], (bfhi(v.w) - mean) * rstd * g1[3] + b1[3]);
            *(LAS u32x4*)(lds + i * 8192 + s * 64 + q * 16) = w;
        }
    }
    __syncthreads();
    {
        const int g = wid >> 1, hh = lane >> 5, l32 = lane & 31, i16 = lane & 15, g16 = lane >> 4;
        const unsigned troff = (unsigned)((4 * hh + (i16 >> 2)) * 64 + (16 * (g16 & 1) + 4 * (i16 & 3)) * 2);
#pragma unroll 1
        for (int nti = 0; nti < 2; ++nti) {
            const int nt = (wid & 1) ? (1 + nti) : (nti * 3);
            f32x16 acc[4];
#pragma unroll
            for (int mt = 0; mt < 4; ++mt)
#pragma unroll
                for (int e = 0; e < 16; ++e) acc[mt][e] = 0.f;
            const bf16_t* wrow = wsp + (size_t)(g * 128 + nt * 32 + l32) * 128 + 4 * hh;
            const int nkk = 2 * nt + 2;
            bf16x8 bfr[8];
#pragma unroll
            for (int kk = 0; kk < 8; ++kk) {
                u32x4 bw = {0u, 0u, 0u, 0u};
                if (kk < nkk) { const u32x2 lo = *(const u32x2*)(wrow + kk * 16), hi = *(const u32x2*)(wrow + kk * 16 + 8); bw.x = lo.x; bw.y = lo.y; bw.z = hi.x; bw.w = hi.y; }
                bfr[kk] = __builtin_bit_cast(bf16x8, bw);
            }
#pragma unroll
            for (int kk = 0; kk < 8; ++kk) {
                if (kk < nkk) {
#pragma unroll
                    for (int mt = 0; mt < 4; ++mt) {
                        LAS const unsigned char* ap = lds + (4 * g + mt) * 8192 + kk * 1024 + troff;
                        const bf16x8 afrag = cat8(tr_read(ap), tr_read(ap + 512));
                        acc[mt] = MFMA32(afrag, bfr[kk], acc[mt]);
                    }
                }
            }
            const int t = nt * 32 + l32; const size_t row = (size_t)(row0 + t);
            const float bs = bsp[g * 128 + t];
#pragma unroll
            for (int mt = 0; mt < 4; ++mt)
#pragma unroll
                for (int a = 0; a < 4; ++a) {
                    const int c0 = g * 128 + mt * 32 + a * 8 + 4 * hh;
                    const u32x2 uu = *(const u32x2*)(mid + row * MID_LD + c0);
                    u32x2 w;
                    w.x = pk2(bflo(uu.x) * (acc[mt][4 * a + 0] + bs), bfhi(uu.x) * (acc[mt][4 * a + 1] + bs));
                    w.y = pk2(bflo(uu.y) * (acc[mt][4 * a + 2] + bs), bfhi(uu.y) * (acc[mt][4 * a + 3] + bs));
                    *(u32x2*)(act + row * ACT_LD + 1024 + c0) = w;
                }
        }
    }
    __syncthreads();
}

__device__ __forceinline__ void pool_unit(LAS unsigned char* lds, int b, int tl, const bf16_t* mid, const bf16_t* wpt, const float* pscale, bf16_t* act) {
    const int tid = opaque_tid(), lane = tid & 63, wid = tid >> 6;
    const int row0 = b * SEQ + tl * 128, pos0 = tl * 128;
    const int hh = lane >> 5, l32 = lane & 31;
    LAS unsigned char* xa = lds;
    LAS unsigned char* dt = lds + 40960;
    u32x4 sv[5];
#define POOL_LOAD(gg) do { _Pragma("unroll") for (int k5 = 0; k5 < 5; ++k5) { const int item = tid + k5 * 512, r = item >> 4, chn = item & 15, pos = pos0 - 16 + r; \
            sv[k5] = (u32x4){0u, 0u, 0u, 0u}; \
            if (item < 144 * 16 && pos >= 0) sv[k5] = *(const u32x4*)(mid + (size_t)(row0 - 16 + r) * MID_LD + 2560 + (gg) * 128 + chn * 8); } } while (0)
    POOL_LOAD(0);
#pragma unroll
    for (int g = 0; g < 4; ++g) {
        const int w = 2 << g;
#pragma unroll
        for (int k5 = 0; k5 < 5; ++k5) { const int item = tid + k5 * 512, r = item >> 4, chn = item & 15; if (item < 144 * 16) *(LAS u32x4*)(xa + r * 272 + chn * 16) = sv[k5]; }
        __syncthreads();
        if (g < 3) POOL_LOAD(g + 1);
#pragma unroll 1
        for (int it = 0; it < 4; ++it) {
            const int item = tid + it * 512, t = item >> 4, chn = item & 15;
            const int pos = pos0 + t, cnt = (pos + 1 < w) ? pos + 1 : w;
            LAS const unsigned char* xp = xa + (t + 16) * 272 + chn * 16;
            const u32x4 x0 = *(const LAS u32x4*)xp;
            float a[8] = {0.f, 0.f, 0.f, 0.f, 0.f, 0.f, 0.f, 0.f};
#pragma unroll
            for (int j = 0; j < w; ++j) { const u32x4 xv = *(const LAS u32x4*)(xp - j * 272);
                a[0] += bflo(xv.x); a[1] += bfhi(xv.x); a[2] += bflo(xv.y); a[3] += bfhi(xv.y); a[4] += bflo(xv.z); a[5] += bfhi(xv.z); a[6] += bflo(xv.w); a[7] += bfhi(xv.w); }
            const float inv = 1.0f / (float)cnt;
            u32x4 o; o.x = pk2(a[0] * inv - bflo(x0.x), a[1] * inv - bfhi(x0.x)); o.y = pk2(a[2] * inv - bflo(x0.y), a[3] * inv - bfhi(x0.y));
            o.z = pk2(a[4] * inv - bflo(x0.z), a[5] * inv - bfhi(x0.z)); o.w = pk2(a[6] * inv - bflo(x0.w), a[7] * inv - bfhi(x0.w));
            *(LAS u32x4*)(dt + t * 272 + chn * 16) = o;
        }
        __syncthreads();
        {
            const int mt = wid & 3, nt0 = (wid >> 2) * 2;
            bf16x8 af[8];
            const bf16_t* ap = wpt + (size_t)(g * 128 + mt * 32 + l32) * 128 + 8 * hh;
#pragma unroll
            for (int kk = 0; kk < 8; ++kk) af[kk] = *(const bf16x8*)(ap + kk * 16);
#pragma unroll 1
            for (int nti = 0; nti < 2; ++nti) {
                const int nt = nt0 + nti;
                f32x16 acc;
#pragma unroll
                for (int e = 0; e < 16; ++e) acc[e] = 0.f;
                LAS const unsigned char* bp = dt + (nt * 32 + l32) * 272 + 16 * hh;
#pragma unroll
                for (int kk = 0; kk < 8; ++kk) { const bf16x8 bf = *(const LAS bf16x8*)(bp + kk * 32); acc = MFMA32(af[kk], bf, acc); }
                const size_t row = (size_t)(row0 + nt * 32 + l32);
#pragma unroll
                for (int a = 0; a < 4; ++a) { const int dd = g * 128 + mt * 32 + a * 8 + 4 * hh; const f32x4 sc = *(const f32x4*)(pscale + dd);
                    u32x2 o; o.x = pk2(acc[4 * a] * sc[0], acc[4 * a + 1] * sc[1]); o.y = pk2(acc[4 * a + 2] * sc[2], acc[4 * a + 3] * sc[3]);
                    *(u32x2*)(act + row * ACT_LD + 2048 + dd) = o; }
            }
        }
        __syncthreads();
    }
#undef POOL_LOAD
}

constexpr int ATT_SLOT = 8704, ATT_WIN = 13, ATT_BACK = 5, ATT_PRIV = ATT_WIN * ATT_SLOT;
static_assert(ATT_PRIV + 8 * 4096 <= LDS_BYTES, "attention LDS map");
__device__ __forceinline__ void attn_wg(LAS unsigned char* lds, int b, int h, int qb0, const bf16_t* mid, bf16_t* act, int tid) {
    const int lane = tid & 63, wid = __builtin_amdgcn_readfirstlane(tid >> 6);
    const int hh = lane >> 5, ql = lane & 31, i16 = lane & 15, g16 = lane >> 4;
    const int qb = qb0 + wid;
    const int win_lo = qb0 > ATT_BACK ? qb0 - ATT_BACK : 0, nwin = qb0 + 8 - win_lo;
    const size_t rowq = (size_t)b * SEQ + qb * 32 + ql;
    bf16x8 qf[4];
#pragma unroll
    for (int kk = 0; kk < 4; ++kk) qf[kk] = *(const bf16x8*)(mid + rowq * MID_LD + 1024 + h * 64 + kk * 16 + 8 * hh);
    {
        const int isv = tid >> 8, t8 = tid & 255, row = t8 >> 3, ch = t8 & 7;
        const bf16_t* src = mid + ((size_t)b * SEQ + row) * MID_LD + (isv ? 2048 : 1536) + h * 64 + ch * 8;
        const unsigned dsto = isv ? (unsigned)(4608 + (ch >> 2) * 2048 + row * 64 + (ch & 3) * 16) : (unsigned)(row * 144 + ch * 16);
        u32x4 v[ATT_WIN];
#pragma unroll
        for (int i = 0; i < ATT_WIN; ++i) if (i < nwin) v[i] = *(const u32x4*)(src + (size_t)(win_lo + i) * 32 * MID_LD);
#pragma unroll
        for (int i = 0; i < ATT_WIN; ++i) if (i < nwin) *(LAS u32x4*)(lds + i * ATT_SLOT + dsto) = v[i];
    }
    __syncthreads();
    f32x16 o0, o1;
#pragma unroll
    for (int e = 0; e < 16; ++e) { o0[e] = 0.f; o1[e] = 0.f; }
    float C = 1.0f;
    const unsigned troff = (unsigned)((4 * hh + (i16 >> 2)) * 64 + (16 * (g16 & 1) + 4 * (i16 & 3)) * 2);
    LAS unsigned char* vl = lds + ATT_PRIV + wid * 4096;
    const bf16_t* kbase = mid + ((size_t)b * SEQ + ql) * MID_LD + 1536 + h * 64 + 8 * hh;
    const bf16_t* vbase = mid + ((size_t)b * SEQ + ql) * MID_LD + 2048 + h * 64 + 8 * hh;
#pragma unroll 1
    for (int kt = qb; kt >= 0; --kt) {
        f32x16 s;
#pragma unroll
        for (int e = 0; e < 16; ++e) s[e] = 0.f;
        LAS const unsigned char* vimg;
        if (kt >= win_lo) {
            LAS const unsigned char* sl = lds + (kt - win_lo) * ATT_SLOT;
#pragma unroll
            for (int kk = 0; kk < 4; ++kk) { const bf16x8 kf = *(const LAS bf16x8*)(sl + ql * 144 + kk * 32 + hh * 16); s = MFMA32(kf, qf[kk], s); }
            vimg = sl + 4608;
        } else {
            bf16x8 kf[4]; u32x4 vv[4];
#pragma unroll
            for (int c = 0; c < 4; ++c) { kf[c] = *(const bf16x8*)(kbase + (size_t)kt * 32 * MID_LD + c * 16); vv[c] = *(const u32x4*)(vbase + (size_t)kt * 32 * MID_LD + c * 16); }
#pragma unroll
            for (int c = 0; c < 4; ++c) { const int chn = hh + 2 * c; *(LAS u32x4*)(vl + (chn >> 2) * 2048 + ql * 64 + (chn & 3) * 16) = vv[c]; }
#pragma unroll
            for (int kk = 0; kk < 4; ++kk) s = MFMA32(kf[kk], qf[kk], s);
            vimg = vl;
        }
        float bt[16], om[16];
        const bool diag = (kt == qb);
#pragma unroll
        for (int r = 0; r < 16; ++r) {
            const float e = __builtin_amdgcn_exp2f(fminf(s[r] * LOG2E, 100.0f));
            float o1_ = __builtin_amdgcn_rcpf(1.0f + e), b1 = e * o1_;
            const int keyl = 8 * (r >> 2) + 4 * hh + (r & 3);
            if (diag && keyl >= ql) { o1_ = 1.0f; b1 = 0.0f; }
            om[r] = o1_; bt[r] = b1;
        }
        float g4[4], pg[4];
#pragma unroll
        for (int a = 0; a < 4; ++a) g4[a] = (om[4 * a] * om[4 * a + 1]) * (om[4 * a + 2] * om[4 * a + 3]);
#pragma unroll
        for (int a = 0; a < 4; ++a) pg[a] = shx(g4[a], lane, 32);
        float after = 1.0f; float pa[16];
#pragma unroll
        for (int a = 3; a >= 0; --a) {
            const float s3 = C * after * (hh == 0 ? pg[a] : 1.0f), s2 = s3 * om[4 * a + 3], s1 = s2 * om[4 * a + 2], s0 = s1 * om[4 * a + 1];
            pa[4 * a + 3] = bt[4 * a + 3] * s3; pa[4 * a + 2] = bt[4 * a + 2] * s2; pa[4 * a + 1] = bt[4 * a + 1] * s1; pa[4 * a + 0] = bt[4 * a + 0] * s0;
            after *= g4[a] * pg[a];
        }
        C *= after;
#pragma unroll
        for (int kk2 = 0; kk2 < 2; ++kk2) {
            u32x4 pw; pw.x = pk2(pa[8 * kk2 + 0], pa[8 * kk2 + 1]); pw.y = pk2(pa[8 * kk2 + 2], pa[8 * kk2 + 3]); pw.z = pk2(pa[8 * kk2 + 4], pa[8 * kk2 + 5]); pw.w = pk2(pa[8 * kk2 + 6], pa[8 * kk2 + 7]);
            const bf16x8 pf = __builtin_bit_cast(bf16x8, pw);
            LAS const unsigned char* ap = vimg + kk2 * 1024 + troff;
            const bf16x8 a0 = cat8(tr_read(ap), tr_read(ap + 512));
            const bf16x8 a1 = cat8(tr_read(ap + 2048), tr_read(ap + 2048 + 512));
            o0 = MFMA32(a0, pf, o0); o1 = MFMA32(a1, pf, o1);
        }
        if (__all(C < 1.0e-38f)) break;
    }
    bf16_t* op = act + rowq * ACT_LD + 1536 + h * 64 + 4 * hh;
#pragma unroll
    for (int a = 0; a < 4; ++a) {
        u32x2 w0, w1; w0.x = pk2(o0[4 * a], o0[4 * a + 1]); w0.y = pk2(o0[4 * a + 2], o0[4 * a + 3]); w1.x = pk2(o1[4 * a], o1[4 * a + 1]); w1.y = pk2(o1[4 * a + 2], o1[4 * a + 3]);
        *(u32x2*)(op + a * 8) = w0; *(u32x2*)(op + 32 + a * 8) = w1;
    }
    __syncthreads();
}

__global__ void __launch_bounds__(512, 2) fwd_megakernel(Params p) {
    extern __shared__ __attribute__((aligned(16))) unsigned char lds_raw[];
    LAS unsigned char* lds = (LAS unsigned char*)lds_raw;
    cg::grid_group grid = cg::this_grid();
    unsigned* const gbar = (unsigned*)p.ws; unsigned gtarget = 0;
#define GSYNC() do { asm volatile("s_waitcnt vmcnt(0) lgkmcnt(0)" ::: "memory"); __syncthreads(); gtarget = (unsigned)__builtin_amdgcn_readfirstlane((int)(gtarget + gridDim.x)); \
        if (threadIdx.x == 0) { __builtin_amdgcn_fence(__ATOMIC_RELEASE, "agent"); asm volatile("s_waitcnt vmcnt(0)" ::: "memory"); \
            __hip_atomic_fetch_add(gbar, 1u, __ATOMIC_RELAXED, __HIP_MEMORY_SCOPE_AGENT); \
            while (__hip_atomic_load(gbar, __ATOMIC_RELAXED, __HIP_MEMORY_SCOPE_AGENT) < gtarget) __builtin_amdgcn_s_sleep(2); } \
        __syncthreads(); __builtin_amdgcn_fence(__ATOMIC_ACQUIRE, "agent"); asm volatile("s_waitcnt vmcnt(0)" ::: "memory"); } while (0)
    unsigned xtarget = 0;
#define XSYNC() do { asm volatile("s_waitcnt vmcnt(0) lgkmcnt(0)" ::: "memory"); __syncthreads(); xtarget = (unsigned)__builtin_amdgcn_readfirstlane((int)(xtarget + (unsigned)X.cnt)); \
        if (threadIdx.x == 0) { __hip_atomic_fetch_add(xbar, 1u, __ATOMIC_RELAXED, __HIP_MEMORY_SCOPE_AGENT); \
            while (__hip_atomic_load(xbar, __ATOMIC_RELAXED, __HIP_MEMORY_SCOPE_AGENT) < xtarget) __builtin_amdgcn_s_sleep(1); } \
        __syncthreads(); __builtin_amdgcn_fence(__ATOMIC_ACQUIRE, "agent"); asm volatile("s_waitcnt vmcnt(0)" ::: "memory"); } while (0)
    grid.sync();
    const int G = gridDim.x, bid = blockIdx.x, tid = threadIdx.x;
    typedef const Params __attribute__((address_space(4)))* KArg;
    KArg kp = (KArg)__builtin_amdgcn_kernarg_segment_ptr();

    pg8::XInfo X;
    { LAS unsigned* sh = (LAS unsigned*)(lds + 131072);
      if (tid == 0) { const unsigned xc = (unsigned)__builtin_amdgcn_s_getreg((3 << 11) | 20) & 0xFu;
          sh[0] = xc; sh[1] = __hip_atomic_fetch_add(gbar + 64 + 64 * xc, 1u, __ATOMIC_RELAXED, __HIP_MEMORY_SCOPE_AGENT); }
      __syncthreads();
      const unsigned xcc = sh[0]; X.r = (int)sh[1];
      p0_prologue(p, lds);
      GSYNC();
      int nx = 0, xi = 0, cnt = 0;
      for (unsigned j = 0; j < 16; ++j) { const unsigned cj = __hip_atomic_load(gbar + 64 + 64 * j, __ATOMIC_RELAXED, __HIP_MEMORY_SCOPE_AGENT); if (cj) { if (j == xcc) { xi = nx; cnt = (int)cj; } ++nx; } }
      X.xi = __builtin_amdgcn_readfirstlane(xi); X.nx = __builtin_amdgcn_readfirstlane(nx); X.cnt = __builtin_amdgcn_readfirstlane(cnt); X.r = __builtin_amdgcn_readfirstlane(X.r);
      X.nbx = (NB - X.xi + X.nx - 1) / X.nx; }
    unsigned* const xbar = gbar + 2048 + 64 * __builtin_amdgcn_readfirstlane((int)((LAS unsigned*)(lds + 131072))[0]);
#pragma unroll 1
    for (int l = 0; l < NL; ++l) {
        KArg q = kp; asm volatile("" : "+s"(q));
        unsigned char* ws = q->ws; float* xout = q->out;
        float* MOD = (float*)(ws + WS_MOD);
        bf16_t* WSP = (bf16_t*)(ws + WS_WSP); bf16_t* WPT = (bf16_t*)(ws + WS_WPT);
        bf16_t* WIN = (bf16_t*)(ws + WS_WIN); bf16_t* WMG = (bf16_t*)(ws + WS_WMG); bf16_t* WOUT = (bf16_t*)(ws + WS_WOUT);
        bf16_t* WFI = (bf16_t*)(ws + WS_WFI); bf16_t* WFO = (bf16_t*)(ws + WS_WFO);
        bf16_t* ACT = (bf16_t*)(ws + WS_ACT); bf16_t* MID = (bf16_t*)(ws + WS_MID); bf16_t* MRG = (bf16_t*)(ws + WS_MRG); bf16_t* FB = (bf16_t*)(ws + WS_F);
        const float* xs = (l == 0) ? q->in[I_X] : xout;
        const float* modl = MOD + (size_t)l * NB * NMOD;
        norm_phase(X, xs, q->in[I_G1] + l * DM, modl, 0, DM, ACT);
        XSYNC();
        { pg8::Gemm g{ACT, WIN + (size_t)l * 3072 * DM, ACT_LD, DM}; pg8::StaticOrder S; S.init(X, 3072, 16); pg8::EpiIn E{MID};
          pg8::gemm_phase<pg8::EpiIn, pg8::StaticOrder>(lds, g, S, E); }
        XSYNC();
        for (int u = X.r; u < X.nbx * 16; u += X.cnt)
            gmlp_unit(lds, X.xi + (u >> 4) * X.nx, u & 15, MID, WSP + (size_t)l * 4 * 128 * 128, q->in[I_LNG] + l * BW, q->in[I_LNB] + l * BW, q->in[I_BSP] + l * 4 * 128, ACT);
        for (int u = X.r; u < X.nbx * 16; u += X.cnt)
            pool_unit(lds, X.xi + (u >> 4) * X.nx, u & 15, MID, WPT + (size_t)l * 4 * 128 * 128, q->in[I_PS] + l * BW, ACT);
        { const int t2 = opaque_tid();
          for (int wu = X.r; wu < X.nbx * 64; wu += X.cnt) { const int bhl = wu >> 3;
              attn_wg(lds, X.xi + (bhl >> 3) * X.nx, bhl & 7, (wu & 7) * 8, MID, ACT, t2); } }
        XSYNC();
        { const int sb = X.xi + (X.r >> 5) * X.nx;
          unsigned char* scr = ws + WS_SCR + (size_t)sb * SEQ * MID_LD * 2 + (size_t)(X.r & 31) * SCR_PER_WG;
          pg8::Gemm g{ACT, WMG + (size_t)l * DM * WMG_LD, ACT_LD, WMG_LD}; pg8::MergeOrder S; S.init(X);
          pg8::EpiMerge E{(u32x4*)scr, (u32x4*)(scr + 131072), MRG};
          pg8::gemm_phase<pg8::EpiMerge, pg8::MergeOrder>(lds, g, S, E); }
        XSYNC();
        { pg8::Gemm g{MRG, WOUT + (size_t)l * DM * DM, DM, DM}; pg8::StaticOrder S; S.init(X, DM, 16); pg8::EpiRes E{xs, xout, modl + 2 * DM};
          pg8::gemm_phase<pg8::EpiRes, pg8::StaticOrder>(lds, g, S, E); }
        XSYNC();
        norm_phase(X, xout, q->in[I_G2] + l * DM, modl, 3 * DM, 4 * DM, ACT);
        XSYNC();
        { pg8::Gemm g{ACT, WFI + (size_t)l * 2 * FF * DM, ACT_LD, DM}; pg8::StaticOrder S; S.init(X, 2 * FF, 16); pg8::EpiFfn E{FB};
          pg8::gemm_phase<pg8::EpiFfn, pg8::StaticOrder>(lds, g, S, E); }
        XSYNC();
        { pg8::Gemm g{FB, WFO + (size_t)l * DM * FF, MID_LD, FF}; pg8::StaticOrder S; S.init(X, DM, FF / 64); pg8::EpiRes E{xout, xout, modl + 5 * DM};
          pg8::gemm_phase<pg8::EpiRes, pg8::StaticOrder>(lds, g, S, E); }
        XSYNC();
    }
    final_norm(X, kp->out, kp->in[I_FG]);
}

extern "C" void kernel_launch(void* const* d_in, const int* in_sizes, int n_in, void* d_out, int out_size, void* d_ws, size_t ws_size, hipStream_t stream) {
    static int grid = 0;
    if (grid == 0) {
        if (n_in != 18 || in_sizes[0] != NTOK * DM || out_size != NTOK * DM || ws_size < WS_END) {
            fprintf(stderr, "kernel_launch: unexpected shapes (n_in %d, in0 %d, out %d, ws %zu, need %zu)\n", n_in, n_in > 0 ? in_sizes[0] : -1, out_size, ws_size, (size_t)WS_END); grid = -1; return; }
        int dev = 0, cus = 0, per_cu = 0;
        if (hipGetDevice(&dev) != hipSuccess || hipDeviceGetAttribute(&cus, hipDeviceAttributeMultiprocessorCount, dev) != hipSuccess) { grid = -1; return; }
        if (hipFuncSetAttribute((const void*)fwd_megakernel, hipFuncAttributeMaxDynamicSharedMemorySize, LDS_BYTES) != hipSuccess) { fprintf(stderr, "kernel_launch: hipFuncSetAttribute failed\n"); grid = -1; return; }
        if (hipOccupancyMaxActiveBlocksPerMultiprocessor(&per_cu, (const void*)fwd_megakernel, 512, LDS_BYTES) != hipSuccess || per_cu < 1) { fprintf(stderr, "kernel_launch: occupancy query gave %d\n", per_cu); per_cu = 1; }
        (void)hipGetLastError();
        grid = cus < MAX_GRID ? cus : MAX_GRID;
    }
    if (grid < 0) return;
    if (hipMemsetAsync(d_ws, 0, 16384, stream) != hipSuccess) { fprintf(stderr, "kernel_launch: memset failed\n"); return; }
    Params p{};
    for (int i = 0; i < 18; ++i) p.in[i] = (const float*)d_in[i];
    p.out = (float*)d_out; p.ws = (unsigned char*)d_ws;
    p.ph_lo = 0; p.ph_hi = 46; p.coop = 1;
    void* args[] = {&p};
    hipError_t e = hipLaunchCooperativeKernel((const void*)fwd_megakernel, dim3(grid), dim3(512), args, LDS_BYTES, stream);
    if (e != hipSuccess) fprintf(stderr, "cooperative launch failed: %s (grid %d)\n", hipGetErrorString(e), grid);
}
```
